# Optimizing an MI355X kernel written in HIP

```python
import math
import jax, jax.numpy as jnp
from jax import lax
import numpy as np

D_MODEL = 1024
BATCH = 8
SEQ = 4096
DEPTH = 1

HEAD_DIM = 64
MIX_WIDTH = D_MODEL
POOL_WIDTH = MIX_WIDTH // 4
POOL_GROUPS = 4
POOL_GROUP_DIM = POOL_WIDTH // POOL_GROUPS
POOL_WINDOWS = (2, 4, 8, 16)
FOX_WIDTH = MIX_WIDTH // 2
FOX_HEADS = FOX_WIDTH // HEAD_DIM
MEM_HEADS = 4
MEM_WIDTH = MEM_HEADS * HEAD_DIM
N_MEM = 256
Q_BLOCK = 128
EPS = 1e-6
SPLIT_SIZES = (POOL_WIDTH, POOL_WIDTH, FOX_WIDTH, FOX_WIDTH, FOX_WIDTH, FOX_HEADS, FOX_WIDTH, MEM_WIDTH, MEM_WIDTH)
IN_WIDTH = sum(SPLIT_SIZES)

kernel_name = "hymba_pool_fox_memory_layer"


def rms_norm(x, g):
    xf = x.astype(jnp.float32)
    y = xf * lax.rsqrt(jnp.mean(xf * xf, axis=-1, keepdims=True) + EPS)
    return (y * g.astype(jnp.float32)).astype(x.dtype)


def split_cols(proj):
    parts, off = [], 0
    for w in SPLIT_SIZES:
        parts.append(proj[..., off:off + w])
        off += w
    return parts


def to_heads(t, n_heads):
    b, s, _ = t.shape
    return t.reshape(b, s, n_heads, HEAD_DIM).transpose(0, 2, 1, 3)


def from_heads(t):
    b, h, s, d = t.shape
    return t.transpose(0, 2, 1, 3).reshape(b, s, h * d)


def pool_mixer(u, w_pool, scale):
    b, s, _ = u.shape
    uf = u.reshape(b, s, POOL_GROUPS, POOL_GROUP_DIM).astype(jnp.float32)
    csum = jnp.cumsum(uf, axis=1)
    pos = jnp.arange(1, s + 1, dtype=jnp.float32)
    pooled = []
    for g, w in enumerate(POOL_WINDOWS):
        cg = csum[:, :, g]
        lag = jnp.pad(cg, ((0, 0), (w, 0), (0, 0)))[:, :s]
        count = jnp.minimum(pos, float(w))
        pooled.append((cg - lag) / count[None, :, None])
    pooled = jnp.stack(pooled, axis=2)
    d = (pooled - uf).astype(u.dtype)
    y = jnp.einsum('bsgc,gce->bsge', d, w_pool).reshape(b, s, POOL_WIDTH)
    return y * scale


def fox_attention(q, k, v, logf):
    b, h, s, dh = q.shape
    n_blocks = s // Q_BLOCK
    F = jnp.cumsum(logf.astype(jnp.float32), axis=-1)
    qb = q.reshape(b, h, n_blocks, Q_BLOCK, dh).transpose(2, 0, 1, 3, 4)
    Fb = F.reshape(b, h, n_blocks, Q_BLOCK).transpose(2, 0, 1, 3)
    pos_k = jnp.arange(s)
    scale = 1.0 / math.sqrt(dh)

    def block(args):
        qi, Fi, i = args
        logits = jnp.einsum('bhqd,bhkd->bhqk', qi, k).astype(jnp.float32) * scale
        logits = logits + Fi[..., None] - F[:, :, None, :]
        pos_q = i * Q_BLOCK + jnp.arange(Q_BLOCK)
        causal = pos_k[None, :] <= pos_q[:, None]
        logits = jnp.where(causal, logits, -1e30)
        p = jax.nn.softmax(logits, axis=-1)
        return jnp.einsum('bhqk,bhkd->bhqd', p.astype(v.dtype), v)

    out = lax.map(block, (qb, Fb, jnp.arange(n_blocks)))
    return out.transpose(1, 2, 0, 3, 4).reshape(b, h, s, dh)


def memory_attention(q, k, v):
    scale = 1.0 / math.sqrt(q.shape[-1])
    logits = jnp.einsum('bhqd,bhmd->bhqm', q, k).astype(jnp.float32) * scale
    p = jax.nn.softmax(logits, axis=-1)
    return jnp.einsum('bhqm,bhmd->bhqd', p.astype(v.dtype), v)


def setup_inputs(seed: int = 0) -> dict:
    key = jax.random.key(seed)
    ks = jax.random.split(key, 16)
    f32 = jnp.float32
    x = jax.random.normal(ks[0], (BATCH, SEQ, D_MODEL), f32)
    mem = jax.random.normal(ks[1], (BATCH, N_MEM, D_MODEL), f32)
    norm_g = 1.0 + 0.02 * jax.random.normal(ks[2], (DEPTH, D_MODEL), f32)
    w_in = jax.random.normal(ks[3], (DEPTH, D_MODEL, IN_WIDTH), f32) * D_MODEL ** -0.5
    b_f = 1.0 + 4.0 * jax.random.uniform(ks[4], (DEPTH, FOX_HEADS), f32)
    w_pool = jax.random.normal(ks[5], (DEPTH, POOL_GROUPS, POOL_GROUP_DIM, POOL_GROUP_DIM), f32) * POOL_GROUP_DIM ** -0.5
    pool_scale = 1.0 + 0.02 * jax.random.normal(ks[6], (DEPTH, POOL_WIDTH), f32)
    fox_q_g = 1.0 + 0.02 * jax.random.normal(ks[7], (DEPTH, HEAD_DIM), f32)
    fox_k_g = 1.0 + 0.02 * jax.random.normal(ks[8], (DEPTH, HEAD_DIM), f32)
    mem_norm_g = 1.0 + 0.02 * jax.random.normal(ks[9], (DEPTH, D_MODEL), f32)
    w_mem_kv = jax.random.normal(ks[10], (DEPTH, D_MODEL, 2 * MEM_WIDTH), f32) * D_MODEL ** -0.5
    mem_q_g = 1.0 + 0.02 * jax.random.normal(ks[11], (DEPTH, HEAD_DIM), f32)
    mem_k_g = 1.0 + 0.02 * jax.random.normal(ks[12], (DEPTH, HEAD_DIM), f32)
    w_out = jax.random.normal(ks[13], (DEPTH, MIX_WIDTH, D_MODEL), f32) * MIX_WIDTH ** -0.5
    return {"x": x, "mem": mem, "norm_g": norm_g, "w_in": w_in, "b_f": b_f,
            "w_pool": w_pool, "pool_scale": pool_scale, "fox_q_g": fox_q_g,
            "fox_k_g": fox_k_g, "mem_norm_g": mem_norm_g, "w_mem_kv": w_mem_kv,
            "mem_q_g": mem_q_g, "mem_k_g": mem_k_g, "w_out": w_out}


def reference(x, mem, norm_g, w_in, b_f, w_pool, pool_scale, fox_q_g, fox_k_g,
              mem_norm_g, w_mem_kv, mem_q_g, mem_k_g, w_out):
    for l in range(DEPTH):
        h = rms_norm(x, norm_g[l])
        proj = jnp.einsum('bsd,de->bse', h, w_in[l])
        u_a, g_a, q_b, k_b, v_b, f_b, g_b, q_m, g_m = split_cols(proj)

        y_a = pool_mixer(u_a, w_pool[l], pool_scale[l])

        q = rms_norm(to_heads(q_b, FOX_HEADS), fox_q_g[l])
        k = rms_norm(to_heads(k_b, FOX_HEADS), fox_k_g[l])
        v = to_heads(v_b, FOX_HEADS)
        logf = jax.nn.log_sigmoid((f_b + b_f[l]).astype(jnp.float32)).transpose(0, 2, 1)
        y_b = from_heads(fox_attention(q, k, v, logf))

        mem_n = rms_norm(mem, mem_norm_g[l])
        kv = jnp.einsum('bmd,de->bme', mem_n, w_mem_kv[l])
        k_m = rms_norm(to_heads(kv[..., :MEM_WIDTH], MEM_HEADS), mem_k_g[l])
        v_m = to_heads(kv[..., MEM_WIDTH:], MEM_HEADS)
        q_mh = rms_norm(to_heads(q_m, MEM_HEADS), mem_q_g[l])
        y_m = from_heads(memory_attention(q_mh, k_m, v_m))

        mixed = jnp.concatenate([y_a * jax.nn.silu(g_a),
                                 y_b * jax.nn.silu(g_b),
                                 y_m * jax.nn.silu(g_m)], axis=-1)
        x = x + jnp.einsum('bse,ed->bsd', mixed, w_out[l])
    return x
```

```cpp
#include <hip/hip_runtime.h>
#include <hip/hip_bf16.h>
#include <cstdio>
#include <cstdint>
#include <cmath>

namespace pg8 {
#define PG8_LAS __attribute__((address_space(3)))
typedef unsigned short bf16_t;
typedef short bf16x8 __attribute__((ext_vector_type(8)));
typedef float f32x4 __attribute__((ext_vector_type(4)));
typedef unsigned u32x4 __attribute__((ext_vector_type(4)));
constexpr int BM = 256, BK = 64, HALF = 128, HTB = HALF * BK * 2  , STAGE_BYTES = 8 * HTB, NXCD = 8, WGM = 8;

__host__ __device__ __forceinline__ int lds_byte(int r, int c) { const int st = (r >> 4) * 2 + (c >> 5), rr = r & 15, cc = c & 31, ob = rr * 64 + cc * 2; return st * 1024 + (ob ^ (((ob >> 9) & 1) << 5)); }
__host__ __device__ __forceinline__ void stage_rc(int b, int& R, int& C) { const int st = b / 1024, sb = b % 1024, swz = sb ^ (((sb >> 9) & 1) << 5); R = (st >> 1) * 16 + swz / 64; C = (st & 1) * 32 + (swz % 64) / 2; }
__host__ __device__ __forceinline__ int perm32(int rho) { const int n = rho >> 4, i = rho & 15; return 8 * (i >> 2) + 4 * n + (i & 3); }

struct Unit { int pm, pn; };
struct Gemm { const bf16_t* A; const bf16_t* Bt; int M, N, K; };

struct StaticOrder {
    int nM, nN, nwg, G, c;
    __host__ __device__ void init(int M, int N, int G_, int c_) { nM = M / BM; nN = N / BM; nwg = nM * nN; G = G_; c = c_; }
    __host__ __device__ bool next(int i, Unit& u) const {
        const long L = (long)i * G + c; if (L >= nwg) return false;
        int wgid = (int)L; { const int q = nwg / NXCD, r = nwg % NXCD, xcd = wgid % NXCD, off = wgid / NXCD; wgid = (xcd < r ? xcd * (q + 1) : r * (q + 1) + (xcd - r) * q) + off; }
        const int nig = WGM * nN, gid = wgid / nig, fm = gid * WGM, gsz = (nM - fm) < WGM ? (nM - fm) : WGM;
        u.pm = fm + ((wgid % nig) % gsz); u.pn = (wgid % nig) / gsz; return true;
    }
    __device__ __forceinline__ void a_ready(const Unit&) const {}
    __device__ __forceinline__ void done(const Unit&) const {}
};


typedef float pg8_f32x2 __attribute__((ext_vector_type(2))); typedef __bf16 pg8_bf16x2 __attribute__((ext_vector_type(2)));
__device__ __forceinline__ unsigned cvt_pk_bf16(float lo, float hi) { pg8_f32x2 v = {lo, hi}; pg8_bf16x2 b = __builtin_convertvector(v, pg8_bf16x2); return __builtin_bit_cast(unsigned, b); }

struct OneUnit { int pm, pn;
    __host__ __device__ bool next(int i, Unit& u) const { if (i) return false; u.pm = pm; u.pn = pn; return true; }
    __device__ __forceinline__ void a_ready(const Unit&) const {}
    __device__ __forceinline__ void done(const Unit&) const {}
};
struct EpiProj {
    static constexpr bool PERM = true, AFTER_DRAIN = false;
    bf16_t* O; int ldc; const float* gq; const float* gk; const float* gmq; float qscale; int skip;
    unsigned stg_off;
    template <int MODE> __device__ __forceinline__ void body(const f32x4 (&acc)[2][2][4][2], const Unit& u, int wr, int wc, int fr, int fq, const float* gain, float gs) const {
        int lane = fq * 16 + fr; asm volatile("" : "+v"(lane));
        const int fr_ = lane & 15, fq_ = lane >> 4;
        PG8_LAS unsigned char* sw = (PG8_LAS unsigned char*)(size_t)(stg_off + (unsigned)(wr * 4 + wc) * 2304u);
        PG8_LAS unsigned char* swr = sw + fr_ * 144 + fq_ * 16;
        const PG8_LAS unsigned char* srd = sw + (lane >> 3) * 144 + (lane & 7) * 16;
        bf16_t* gout = O + (size_t)(u.pm * BM + wr * 64 + (lane >> 3)) * ldc + u.pn * BM + wc * 64 + (lane & 7) * 8;
        f32x4 gv[2][2];
        if (MODE == 2) {
#pragma unroll
            for (int bj = 0; bj < 2; ++bj)
#pragma unroll
                for (int n = 0; n < 2; ++n) gv[bj][n] = *(const f32x4*)(gain + bj * 32 + 8 * fq_ + 4 * n) * gs; }
#pragma unroll
        for (int ai = 0; ai < 2; ++ai)
#pragma unroll
            for (int m = 0; m < 4; ++m) {
                float r = 1.f;
                if (MODE == 2) {
                    float ss = 0.f;
#pragma unroll
                    for (int bj = 0; bj < 2; ++bj)
#pragma unroll
                        for (int n = 0; n < 2; ++n) { const f32x4 x = acc[ai][bj][m][n]; ss = fmaf(x[0], x[0], ss); ss = fmaf(x[1], x[1], ss); ss = fmaf(x[2], x[2], ss); ss = fmaf(x[3], x[3], ss); }
                    ss += __shfl_xor(ss, 16); ss += __shfl_xor(ss, 32);
                    r = __builtin_amdgcn_rsqf(ss * (1.0f / 64.0f) + 1e-6f);
                }
#pragma unroll
                for (int bj = 0; bj < 2; ++bj) {
                    f32x4 v0 = acc[ai][bj][m][0], v1 = acc[ai][bj][m][1];
                    if (MODE == 1) {
#pragma unroll
                        for (int i = 0; i < 4; ++i) { v0[i] = v0[i] * __builtin_amdgcn_rcpf(1.0f + __builtin_amdgcn_exp2f(-1.4426950408889634f * v0[i]));
                                                      v1[i] = v1[i] * __builtin_amdgcn_rcpf(1.0f + __builtin_amdgcn_exp2f(-1.4426950408889634f * v1[i])); }
                    } else if (MODE == 2) { v0 = v0 * r * gv[bj][0]; v1 = v1 * r * gv[bj][1]; }
                    u32x4 w; w.x = cvt_pk_bf16(v0[0], v0[1]); w.y = cvt_pk_bf16(v0[2], v0[3]); w.z = cvt_pk_bf16(v1[0], v1[1]); w.w = cvt_pk_bf16(v1[2], v1[3]);
                    *(PG8_LAS u32x4*)(swr + bj * 64) = w;
                }
                const u32x4 o0 = *(const PG8_LAS u32x4*)(srd), o1 = *(const PG8_LAS u32x4*)(srd + 8 * 144);
                bf16_t* gp = gout + (size_t)(ai * HALF + m * 16) * ldc;
                __builtin_nontemporal_store(o0, (u32x4*)(gp)); __builtin_nontemporal_store(o1, (u32x4*)(gp + (size_t)8 * ldc));
            }
    }
    __device__ __forceinline__ void operator()(const f32x4 (&acc)[2][2][4][2], const Unit& u, int wr, int wc, int fr, int fq) const {
        if (skip) return;
        const int pn = u.pn;
        if (pn == 1 || pn == 8 || pn == 9 || pn == 11) body<1>(acc, u, wr, wc, fr, fq, nullptr, 1.f);
        else if (pn == 2 || pn == 3) body<2>(acc, u, wr, wc, fr, fq, gq, qscale);
        else if (pn == 4 || pn == 5) body<2>(acc, u, wr, wc, fr, fq, gk, 1.f);
        else if (pn == 10) body<2>(acc, u, wr, wc, fr, fq, gmq, qscale);
        else body<0>(acc, u, wr, wc, fr, fq, nullptr, 1.f);
    }
};
struct EpiRes {
    static constexpr bool PERM = false, AFTER_DRAIN = false;
    const float* base; float* out; int ldc; int mode;
    __device__ __forceinline__ void operator()(const f32x4 (&acc)[2][2][4][2], const Unit& u, int wr, int wc, int fr, int fq) const {
        const int col0 = u.pn * BM + wc * 32 + 4 * fq;
        if (mode == 2) return;
        if (mode == 1) {
#pragma unroll
            for (int ai = 0; ai < 2; ++ai)
#pragma unroll
                for (int m = 0; m < 4; ++m) { const size_t off = (size_t)(u.pm * BM + ai * HALF + wr * 64 + m * 16 + fr) * ldc + col0;
#pragma unroll
                    for (int bj = 0; bj < 2; ++bj)
#pragma unroll
                        for (int n = 0; n < 2; ++n) *(f32x4*)(out + off + bj * HALF + n * 16) = acc[ai][bj][m][n]; }
            return; }
#pragma unroll
        for (int ai = 0; ai < 2; ++ai) {
            f32x4 bs[4][2][2];
#pragma unroll
            for (int m = 0; m < 4; ++m) { const size_t off = (size_t)(u.pm * BM + ai * HALF + wr * 64 + m * 16 + fr) * ldc + col0;
#pragma unroll
                for (int bj = 0; bj < 2; ++bj)
#pragma unroll
                    for (int n = 0; n < 2; ++n) bs[m][bj][n] = *(const f32x4*)(base + off + bj * HALF + n * 16); }
#pragma unroll
            for (int m = 0; m < 4; ++m) { const size_t off = (size_t)(u.pm * BM + ai * HALF + wr * 64 + m * 16 + fr) * ldc + col0;
#pragma unroll
                for (int bj = 0; bj < 2; ++bj)
#pragma unroll
                    for (int n = 0; n < 2; ++n) *(f32x4*)(out + off + bj * HALF + n * 16) = bs[m][bj][n] + acc[ai][bj][m][n]; }
            asm volatile("" ::: "memory");
        }
    }
};

struct EpiResLds {
    static constexpr bool PERM = false, AFTER_DRAIN = true;
    const float* base; float* out; int ldc; int mode;
    __device__ __forceinline__ void operator()(const f32x4 (&)[2][2][4][2], const Unit&, int, int, int, int) const {}
    __device__ __forceinline__ void fused(f32x4 (&acc)[2][2][4][2], const Unit& u, int wr, int wc, int fr, int fq, PG8_LAS unsigned char* lds, int wid, int lane) const {
        constexpr int RP = 1040;
        if (mode == 2) return;
#pragma unroll
        for (int ai = 0; ai < 2; ++ai) {
            const size_t goff = (size_t)(u.pm * BM + ai * HALF + 16 * wid) * ldc + (size_t)u.pn * BM + 4 * lane;
            f32x4 xr[16];
#pragma unroll
            for (int i = 0; i < 16; ++i) xr[i] = (mode == 1) ? (f32x4){0.f, 0.f, 0.f, 0.f} : __builtin_nontemporal_load((const f32x4*)(base + goff + (size_t)i * ldc));
#pragma unroll
            for (int m = 0; m < 4; ++m)
#pragma unroll
                for (int bj = 0; bj < 2; ++bj)
#pragma unroll
                    for (int n = 0; n < 2; ++n) *(PG8_LAS f32x4*)(lds + (wr * 64 + m * 16 + fr) * RP + (bj * HALF + wc * 32 + n * 16 + 4 * fq) * 4) = acc[ai][bj][m][n];
            asm volatile("s_waitcnt lgkmcnt(0)" ::: "memory"); __builtin_amdgcn_s_barrier(); asm volatile("" ::: "memory");
#pragma unroll
            for (int i = 0; i < 16; ++i) { const f32x4 v = *(const PG8_LAS f32x4*)(lds + (16 * wid + i) * RP + 16 * lane); __builtin_nontemporal_store(v + xr[i], (f32x4*)(out + goff + (size_t)i * ldc)); }
            asm volatile("s_waitcnt lgkmcnt(0)" ::: "memory"); __builtin_amdgcn_s_barrier(); asm volatile("" ::: "memory");
        }
    }
};

template <class Epi, class Sched, bool ALIGN_EPI = false, bool SP2 = false>
__device__ __forceinline__ void gemm_phase(PG8_LAS unsigned char* lds, const Gemm g, const Sched& S, const Epi& E) {
    int tid_ = threadIdx.x; asm volatile("" : "+v"(tid_));
    const int tid = tid_, wid = __builtin_amdgcn_readfirstlane(tid >> 6), lane = tid & 63, wr = wid >> 2, wc = wid & 3, fr = lane & 15, fq = lane >> 4;
    const int K = g.K, nt = K / BK;
    unsigned voffA[2], voffB[2];
#pragma unroll
    for (int i = 0; i < 2; ++i) { int R, C; stage_rc(tid * 16 + i * 8192, R, C); const int Rb = Epi::PERM ? ((R & ~31) + perm32(R & 31)) : R;
        voffA[i] = (unsigned)(R * K + C) * 2u; voffB[i] = (unsigned)(Rb * K + C) * 2u; }
    const size_t kstep = (size_t)(BK * 2);
    const size_t hstep = (size_t)HALF * K * 2;
    const size_t tstep = 2 * hstep;
    const unsigned ldsw = (unsigned)wid * 1024u;
    const int aoff = lds_byte(wr * 64 + fr, fq * 8), boff = lds_byte(wc * 32 + fr, fq * 8);
#define PG8_SA(b, h) (((b) * 2 + (h)) * HTB)
#define PG8_SB(b, h) ((4 + (b) * 2 + (h)) * HTB)
#define PG8_STAGE(bufoff, gbase, voff) do { _Pragma("unroll") for (int _i = 0; _i < 2; ++_i) \
        __builtin_amdgcn_global_load_lds((const unsigned*)((const char*)(gbase) + (voff)[_i]), (PG8_LAS unsigned*)(lds + (bufoff) + ldsw + _i * 8192), 16, 0, 0); } while (0)
#define PG8_LDA(dst, b, h) do { _Pragma("unroll") for (int m = 0; m < 4; ++m) _Pragma("unroll") for (int k = 0; k < 2; ++k) dst[m][k] = *(const PG8_LAS bf16x8*)(lds + PG8_SA(b, h) + aoff + m * 2048 + k * 1024); } while (0)
#define PG8_LDB(dst, b, h) do { _Pragma("unroll") for (int n = 0; n < 2; ++n) _Pragma("unroll") for (int k = 0; k < 2; ++k) dst[n][k] = *(const PG8_LAS bf16x8*)(lds + PG8_SB(b, h) + boff + n * 2048 + k * 1024); } while (0)
#define PG8_MMA(ai, bj, At, Bt) do { __builtin_amdgcn_s_setprio(1); _Pragma("unroll") for (int m = 0; m < 4; ++m) _Pragma("unroll") for (int n = 0; n < 2; ++n) _Pragma("unroll") for (int k = 0; k < 2; ++k) \
        acc[ai][bj][m][n] = __builtin_amdgcn_mfma_f32_16x16x32_bf16(Bt[n][k], At[m][k], acc[ai][bj][m][n], 0, 0, 0); __builtin_amdgcn_s_setprio(0); } while (0)
#define PG8_WAIT_V(n) asm volatile("s_waitcnt vmcnt(" #n ")" ::: "memory")
#define PG8_WAIT_L(n) asm volatile("s_waitcnt lgkmcnt(" #n ")" ::: "memory")
#define PG8_BAR __builtin_amdgcn_s_barrier()
#define PG8_SCHED __builtin_amdgcn_sched_barrier(0)
    Unit cur, nxt; int ui = 0;
    if (!S.next(0, cur)) return;
    f32x4 acc[2][2][4][2];
#pragma unroll
    for (int a = 0; a < 2; ++a)
#pragma unroll
        for (int b = 0; b < 2; ++b)
#pragma unroll
            for (int m = 0; m < 4; ++m)
#pragma unroll
                for (int n = 0; n < 2; ++n) acc[a][b][m][n] = (f32x4){0.f, 0.f, 0.f, 0.f};
    bf16x8 At[4][2], B0[2][2], B1[2][2];
    const char* cA = (const char*)g.A + (size_t)cur.pm * tstep; const char* cB = (const char*)g.Bt + (size_t)cur.pn * tstep;
    S.a_ready(cur);
    if constexpr (SP2) {
        PG8_STAGE(PG8_SB(0, 0), cB, voffB); PG8_STAGE(PG8_SB(0, 1), cB + hstep, voffB); PG8_STAGE(PG8_SA(0, 0), cA, voffA); PG8_STAGE(PG8_SA(0, 1), cA + hstep, voffA);
        if (wr == 1) PG8_BAR;
        PG8_WAIT_V(2); PG8_BAR;
        PG8_STAGE(PG8_SB(1, 0), cB + kstep, voffB); PG8_STAGE(PG8_SA(1, 0), cA + kstep, voffA); PG8_STAGE(PG8_SB(1, 1), cB + hstep + kstep, voffB);
        PG8_WAIT_V(6); PG8_BAR;
    } else {
        PG8_STAGE(PG8_SB(0, 0), cB, voffB); PG8_STAGE(PG8_SA(0, 0), cA, voffA); PG8_STAGE(PG8_SB(0, 1), cB + hstep, voffB); PG8_STAGE(PG8_SA(0, 1), cA + hstep, voffA);
        if (wr == 1) PG8_BAR;
        PG8_WAIT_V(4); PG8_BAR;
        PG8_STAGE(PG8_SB(1, 0), cB + kstep, voffB); PG8_STAGE(PG8_SA(1, 0), cA + kstep, voffA); PG8_STAGE(PG8_SB(1, 1), cB + hstep + kstep, voffB);
        PG8_WAIT_V(6); PG8_BAR;
    }
    for (;;) {
        const bool has_next = S.next(ui + 1, nxt);
        const char* nA = has_next ? (const char*)g.A + (size_t)nxt.pm * tstep : cA; const char* nB = has_next ? (const char*)g.Bt + (size_t)nxt.pn * tstep : cB;
        for (int t = 0; t < nt; t += 2) {
            const bool last = (t == nt - 2);
            const char* a1 = cA + (size_t)(t + 1) * kstep;
            const char* a2 = last ? nA : cA + (size_t)(t + 2) * kstep; const char* b2 = last ? nB : cB + (size_t)(t + 2) * kstep;
            const char* a3 = a2 + kstep; const char* b3 = b2 + kstep;
            if (last && has_next) S.a_ready(nxt);
            if constexpr (SP2) {
            PG8_LDB(B0, 0, 0); PG8_LDB(B1, 0, 1); PG8_SCHED; PG8_LDA(At, 0, 0); PG8_STAGE(PG8_SA(1, 1), a1 + hstep, voffA);
            PG8_WAIT_V(8); PG8_WAIT_L(0); PG8_BAR; PG8_MMA(0, 0, At, B0); PG8_MMA(0, 1, At, B1); PG8_BAR; PG8_SCHED;
            PG8_LDA(At, 0, 1); PG8_STAGE(PG8_SB(0, 0), b2, voffB); PG8_STAGE(PG8_SB(0, 1), b2 + hstep, voffB); PG8_STAGE(PG8_SA(0, 0), a2, voffA);
            PG8_WAIT_V(8); PG8_WAIT_L(0); PG8_BAR; PG8_MMA(1, 0, At, B0); PG8_MMA(1, 1, At, B1); PG8_BAR; PG8_SCHED;
            PG8_LDB(B0, 1, 0); PG8_LDB(B1, 1, 1); PG8_SCHED; PG8_LDA(At, 1, 0); PG8_STAGE(PG8_SA(0, 1), a2 + hstep, voffA);
            PG8_WAIT_V(8); PG8_WAIT_L(0); PG8_BAR; PG8_MMA(0, 0, At, B0); PG8_MMA(0, 1, At, B1); PG8_BAR; PG8_SCHED;
            PG8_LDA(At, 1, 1); PG8_STAGE(PG8_SB(1, 0), b3, voffB); PG8_STAGE(PG8_SB(1, 1), b3 + hstep, voffB); PG8_STAGE(PG8_SA(1, 0), a3, voffA);
            PG8_WAIT_V(8); PG8_WAIT_L(0); PG8_BAR; PG8_MMA(1, 0, At, B0); PG8_MMA(1, 1, At, B1); PG8_BAR; PG8_SCHED;
            } else {
            PG8_LDB(B0, 0, 0); PG8_SCHED; PG8_LDA(At, 0, 0); PG8_STAGE(PG8_SA(1, 1), a1 + hstep, voffA);
            PG8_WAIT_L(8); PG8_BAR; PG8_WAIT_L(0); PG8_MMA(0, 0, At, B0); PG8_BAR; PG8_SCHED;
            PG8_LDB(B1, 0, 1); PG8_STAGE(PG8_SB(0, 0), b2, voffB);
            PG8_BAR; PG8_WAIT_L(0); PG8_MMA(0, 1, At, B1); PG8_BAR;
            PG8_LDA(At, 0, 1); PG8_STAGE(PG8_SA(0, 0), a2, voffA);
            PG8_BAR; PG8_WAIT_L(0); PG8_MMA(1, 0, At, B0); PG8_BAR; PG8_SCHED;
            PG8_STAGE(PG8_SB(0, 1), b2 + hstep, voffB);
            PG8_WAIT_V(6); PG8_BAR; PG8_MMA(1, 1, At, B1); PG8_BAR;
            PG8_LDB(B0, 1, 0); PG8_SCHED; PG8_LDA(At, 1, 0); PG8_STAGE(PG8_SA(0, 1), a2 + hstep, voffA);
            PG8_WAIT_L(8); PG8_BAR; PG8_WAIT_L(0); PG8_MMA(0, 0, At, B0); PG8_BAR; PG8_SCHED;
            PG8_LDB(B1, 1, 1); PG8_STAGE(PG8_SB(1, 0), b3, voffB);
            PG8_BAR; PG8_WAIT_L(0); PG8_MMA(0, 1, At, B1); PG8_BAR;
            PG8_LDA(At, 1, 1); PG8_STAGE(PG8_SA(1, 0), a3, voffA);
            PG8_BAR; PG8_WAIT_L(0); PG8_MMA(1, 0, At, B0); PG8_BAR; PG8_SCHED;
            PG8_STAGE(PG8_SB(1, 1), b3 + hstep, voffB);
            PG8_WAIT_V(6); PG8_BAR; PG8_MMA(1, 1, At, B1); PG8_BAR;
            }
        }
        if constexpr (ALIGN_EPI) { if (wr == 0) PG8_BAR; }
        if constexpr (!Epi::AFTER_DRAIN) { E(acc, cur, wr, wc, fr, fq); S.done(cur); }
        if (!has_next) break;
#pragma unroll
        for (int a = 0; a < 2; ++a)
#pragma unroll
            for (int b = 0; b < 2; ++b)
#pragma unroll
                for (int m = 0; m < 4; ++m)
#pragma unroll
                    for (int n = 0; n < 2; ++n) acc[a][b][m][n] = (f32x4){0.f, 0.f, 0.f, 0.f};
        cur = nxt; cA = nA; cB = nB; ++ui;
        if constexpr (ALIGN_EPI) { if (wr == 1) PG8_BAR; }
    }
    PG8_WAIT_V(0);
    if constexpr (!ALIGN_EPI) { if (wr == 0) PG8_BAR; }
    PG8_BAR;
    if constexpr (Epi::AFTER_DRAIN) { E.fused(acc, cur, wr, wc, fr, fq, lds, wid, lane); S.done(cur); }
#undef PG8_SA
#undef PG8_SB
#undef PG8_STAGE
#undef PG8_LDA
#undef PG8_LDB
#undef PG8_MMA
#undef PG8_WAIT_V
#undef PG8_WAIT_L
#undef PG8_BAR
#undef PG8_SCHED
}
}


namespace attn {
using bf16 = unsigned short;
using bf16x8 = __attribute__((ext_vector_type(8))) short;
using s16x4 = __attribute__((ext_vector_type(4))) short;
using f32x16 = __attribute__((ext_vector_type(16))) float;
using f32x4 = __attribute__((ext_vector_type(4))) float;
using u32x4 = __attribute__((ext_vector_type(4))) unsigned;
constexpr int NW = 8, QBLK = 32, QB = QBLK * NW, KVBLK = 64;
constexpr int NSLOT = 3, SLOTB = 8192;
constexpr int LDS_K = 0, LDS_V = NSLOT * SLOTB, LDS_WS = 2 * NSLOT * SLOTB, LDS_OST = LDS_WS + NW * 64 * 4, LDS_G = LDS_OST + NW * 4096, LDS_GZ = 141312  , LDS_Q = LDS_G + 16384  , LDS_BYTES = LDS_Q + QB * 128;
#define ALAS __attribute__((address_space(3)))
#define SBAR() __builtin_amdgcn_sched_barrier(0)
__device__ __forceinline__ int crow(int r, int hi) { return (r & 3) + 8 * (r >> 2) + 4 * hi; }
__device__ __forceinline__ void cmask(f32x16& p0, f32x16& p1, int jb, int qrel, int hi) {
    const float NEG = -INFINITY; int dq = qrel - 64 * jb - 4 * hi;
    asm volatile("" : "+v"(dq));
#pragma unroll
    for (int r = 0; r < 16; ++r) { const int c = (r & 3) + 8 * (r >> 2); if (c > dq) p0[r] = NEG; if (c + 32 > dq) p1[r] = NEG; }
}
__device__ __forceinline__ void glds16(const void* gsrc, unsigned lds_dst) { unsigned keep;
    asm volatile("s_mov_b32 %0, m0\n\ts_mov_b32 m0, %2\n\ts_nop 0\n\tglobal_load_lds_dwordx4 %1, off\n\ts_mov_b32 m0, %0" : "=&s"(keep) : "v"(gsrc), "s"(lds_dst) : "memory"); }
__device__ __forceinline__ void glds16s(const void* sbase, unsigned voff, unsigned lds_dst) { unsigned keep;
    asm volatile("s_nop 4\n\ts_mov_b32 %0, m0\n\ts_mov_b32 m0, %3\n\ts_nop 0\n\tglobal_load_lds_dwordx4 %1, %2\n\ts_mov_b32 m0, %0" : "=&s"(keep) : "v"(voff), "s"(sbase), "s"(lds_dst) : "memory"); }
__device__ __forceinline__ void st16_wt(void* p, u32x4 v) { asm volatile("global_store_dwordx4 %0, %1, off sc1\n\ts_nop 1" :: "v"(p), "v"(v) : "memory"); }
typedef float f32x2_t __attribute__((ext_vector_type(2))); typedef __bf16 bf16x2_t __attribute__((ext_vector_type(2)));
__device__ __forceinline__ unsigned cvtpk_s(float lo, float hi) { f32x2_t v = {lo, hi}; bf16x2_t b = __builtin_convertvector(v, bf16x2_t); return __builtin_bit_cast(unsigned, b); }
#define WAIT_BAR(N) asm volatile("s_waitcnt vmcnt(" #N ") lgkmcnt(0)\n\ts_barrier" ::: "memory")
typedef ALAS const char* lds_cptr;
typedef short v4i16_t __attribute__((ext_vector_type(4)));
__device__ __forceinline__ void kload2(bf16x8* kf, lds_cptr kp, int kq, int j) { kf[2 * j] = *(const ALAS bf16x8*)(kp + ((32 * j) ^ kq)); kf[2 * j + 1] = *(const ALAS bf16x8*)(kp + ((32 * j) ^ kq) + 4096); }
__device__ __forceinline__ void kload8(bf16x8* kf, lds_cptr kp, int kq) { kload2(kf, kp, kq, 0); kload2(kf, kp, kq, 1); kload2(kf, kp, kq, 2); kload2(kf, kp, kq, 3); }
__device__ __forceinline__ s16x4 vtr(lds_cptr p) { return __builtin_bit_cast(s16x4, __builtin_amdgcn_ds_read_tr16_b64_v4i16((ALAS v4i16_t*)p)); }
__device__ __forceinline__ void bias_split(float gp, unsigned& x0, unsigned& x1) {
    const unsigned b1 = __float_as_uint(gp) & 0xffff0000u; const float r1 = gp - __uint_as_float(b1);
    const unsigned b2 = __float_as_uint(r1) & 0xffff0000u; const float r2 = r1 - __uint_as_float(b2);
    const unsigned b3 = __float_as_uint(r2) & 0xffff0000u;
    x0 = (b1 >> 16) | b2; x1 = (b3 >> 16) | 0x3f800000u;
}
__device__ __forceinline__ unsigned mul_bf16x2(unsigned a, unsigned b) {
    const float al = __uint_as_float(a << 16), ah = __uint_as_float(a & 0xffff0000u), bl = __uint_as_float(b << 16), bh = __uint_as_float(b & 0xffff0000u);
    return cvtpk_s(al * bl, ah * bh);
}

struct Desc {
    const bf16* Q; const bf16* K; const bf16* V; const bf16* gate; bf16* O; const float* G;
    int qpitch, kvpitch, gpitch, opitch;
    int NT, t0, causal, q0;
    float negB;
    int dmaprobe;
    int wt;
    int qpre;
    unsigned* qctr; unsigned hookQ;
    unsigned pendA, pendL; unsigned hookA, hookL;
};

template <class NQ>
__device__ __forceinline__ void unit(const Desc& d, char* shm, const NQ& nextq) {
    const int tid = threadIdx.x, lane = tid & 63, r32 = lane & 31, hi = lane >> 5; const int wid = __builtin_amdgcn_readfirstlane(tid >> 6);
    const int kvp = d.kvpitch, t0 = d.t0, NT = d.NT - t0;
    const bool hasg = d.G != nullptr, causal = d.causal != 0;
    const unsigned lds0 = (unsigned)(uintptr_t)shm;
    const lds_cptr shm3 = (lds_cptr)shm;
    ALAS float* wsf = (ALAS float*)(shm3 + LDS_WS) + wid * 64;
    const long tstep = (long)KVBLK * kvp;
    const bf16* kbase = d.K + (long)(t0 * KVBLK + 8 * wid) * kvp;
    const bf16* vbase = d.V + (long)(t0 * KVBLK + 8 * wid) * kvp;
    const unsigned koff = (unsigned)((lane >> 3) * kvp + (((lane & 7) ^ ((4 * wid + (lane >> 4)) & 7)) * 8)) * 2u;
    const unsigned voff = (unsigned)((lane >> 3) * kvp + (((lane & 7) ^ (((lane >> 4) & 1) * 4)) * 8)) * 2u;
    const unsigned kdst = lds0 + LDS_K + wid * 1024, vdst = lds0 + LDS_V + wid * 1024;
#define DMA_K(t, slot) glds16s(kbase + (long)(t) * tstep, koff, (unsigned)__builtin_amdgcn_readfirstlane(kdst + (slot)))
#define DMA_V(t, slot) glds16s(vbase + (long)(t) * tstep, voff, (unsigned)__builtin_amdgcn_readfirstlane(vdst + (slot)))
    const lds_cptr kp0 = shm3 + LDS_K + r32 * 128;
    const int kq0 = (((r32 >> 1) & 6) << 4) | ((hi ^ ((r32 >> 1) & 1)) << 4);
    const int vq_ = (lane & 15) >> 2, vsw_ = (vq_ >> 1) & 1;
    const lds_cptr vp0 = shm3 + LDS_V + (4 * hi + vq_) * 128 + ((lane >> 4) & 1) * 32 + (lane & 3) * 8 + vsw_ * 64;
    const lds_cptr vp1 = shm3 + LDS_V + (4 * hi + vq_) * 128 + ((lane >> 4) & 1) * 32 + (lane & 3) * 8 + (1 - vsw_) * 64;
    const unsigned qvA = (unsigned)((lane >> 3) * d.qpitch + (((lane & 7) ^ (lane >> 4)) * 8)) * 2u, qvB = qvA ^ 64u;
    const unsigned qdst = lds0 + LDS_Q + wid * 4096;
#define DMA_Q(Qb) do { _Pragma("unroll") for (int j_ = 0; j_ < 4; ++j_) glds16s((Qb) + (long)(wid * QBLK + 8 * j_) * d.qpitch, (j_ & 1) ? qvB : qvA, (unsigned)__builtin_amdgcn_readfirstlane(qdst + j_ * 1024)); } while (0)
    if (!d.qpre) DMA_Q(d.Q);
    if (hasg) { const int plo = (t0 * KVBLK) >> 8, phi = (d.NT * KVBLK - 1) >> 8;
        for (int p = plo + wid; p <= phi; p += NW) glds16s(d.G + p * 256, (unsigned)lane * 16u, (unsigned)__builtin_amdgcn_readfirstlane(lds0 + LDS_G + p * 1024)); }
    const lds_cptr gl0 = hasg ? shm3 + LDS_G + t0 * 256 + lane * 4 : shm3 + LDS_GZ + lane * 4; const int gstep = hasg ? 256 : 0;
    DMA_K(0, 0); DMA_V(0, 0); DMA_K(1, SLOTB);
    bf16x8 qr[4]; float Gref; bf16x8 bq;
#define Q_AND_BIAS() do { \
    _Pragma("unroll") for (int d0 = 0; d0 < 4; ++d0) qr[d0] = *(const ALAS bf16x8*)(shm3 + LDS_Q + wid * 4096 + r32 * 128 + ((32 * d0) ^ kq0));     \
    Gref = hasg ? *(const ALAS float*)(shm3 + LDS_G + d.q0 * 4) : 0.f;                                \
      \
    { const float aq = hasg ? (*(const ALAS float*)(shm3 + LDS_G + (d.q0 + wid * QBLK + r32) * 4) - Gref) + d.negB : d.negB; \
      const unsigned a1 = __float_as_uint(aq) & 0xffff0000u; const float r1 = aq - __uint_as_float(a1); \
      const unsigned a2 = __float_as_uint(r1) & 0xffff0000u; const float r2 = r1 - __uint_as_float(a2); \
      const unsigned a3 = __float_as_uint(r2) & 0xffff0000u; \
      bq = __builtin_bit_cast(bf16x8, (u32x4){0x3f803f80u, 0x3f80u | a1, (a2 >> 16) | a3, 0u}); } } while (0)
    unsigned bx0, bx1;
#define BFRAG0 __builtin_bit_cast(bf16x8, (u32x4){hi ? 0u : bx0, hi ? 0u : bx1, hi ? 0u : 0x3f803f80u, 0u})
#define BFRAG1 __builtin_bit_cast(bf16x8, (u32x4){hi ? bx0 : 0u, hi ? bx1 : 0u, hi ? 0x3f803f80u : 0u, 0u})
#define ZERO16 (f32x16){}
    float l_reg = 0.f; f32x16 o[2]; o[0] = f32x16{}; o[1] = f32x16{};
    const int qrel = wid * QBLK + r32;
    f32x16 pA0, pA1, pB0, pB1; bf16x8 kf[8];
    int sl_prev = 0, sl_cur = 0, sl_next = SLOTB;
#define ROT() do { sl_prev = sl_cur; sl_cur = sl_next; sl_next = (sl_next == (NSLOT - 1) * SLOTB) ? 0 : sl_next + SLOTB; } while (0)
    DMA_K(2, 2 * SLOTB);
    WAIT_BAR(3);
    Q_AND_BIAS();
#define MFMA(a, b, c) __builtin_amdgcn_mfma_f32_32x32x16_bf16(a, b, c, 0, 0, 0)
    bias_split(Gref - *(const ALAS float*)(gl0), bx0, bx1);
    kload8(kf, kp0, kq0);
    pA0 = MFMA(BFRAG0, bq, ZERO16); pA1 = MFMA(BFRAG1, bq, ZERO16);
    pA0 = MFMA(kf[0], qr[0], pA0); pA1 = MFMA(kf[1], qr[0], pA1); pA0 = MFMA(kf[2], qr[1], pA0); pA1 = MFMA(kf[3], qr[1], pA1);
    pA0 = MFMA(kf[4], qr[2], pA0); pA1 = MFMA(kf[5], qr[2], pA1); pA0 = MFMA(kf[6], qr[3], pA0); pA1 = MFMA(kf[7], qr[3], pA1);
    if (causal && NT == 4) cmask(pA0, pA1, 0, qrel, hi);
#pragma unroll
    for (int r = 0; r < 16; ++r) { pA0[r] = __builtin_amdgcn_exp2f(pA0[r]); pA1[r] = __builtin_amdgcn_exp2f(pA1[r]); }
    bias_split(Gref - *(const ALAS float*)(gl0 + gstep), bx0, bx1);
    WAIT_BAR(0);
    if (tid == 0) { *(volatile ALAS unsigned*)(shm3 + d.hookA) = d.pendA; *(volatile ALAS unsigned*)(shm3 + d.hookL) = d.pendL; }
    DMA_K(3, 0); DMA_V(1, SLOTB);
    ROT();
    kload8(kf, kp0 + sl_cur, kq0);
    WAIT_BAR(2);
    s16x4 vlo[4], vhi[4]; u32x4 pw0, pw1, pw2, pw3;
#define PKW(P, B) cvtpk_s(P[B], P[B + 1])
#define PAF(k) __builtin_bit_cast(bf16x8, pw##k)
#define VSL(i) ((((i) & 1) << 1) | (((i) >> 2) & 1))
#define VFR(i) (bf16x8){vlo[VSL(i)][0], vlo[VSL(i)][1], vlo[VSL(i)][2], vlo[VSL(i)][3], vhi[VSL(i)][0], vhi[VSL(i)][1], vhi[VSL(i)][2], vhi[VSL(i)][3]}
#define PIN(x) asm volatile("" : "+v"(x))
#define GAPA(MF, A0, A1, A2, A3, W0, W1, PW) do { MF; sacc += A0; sacc += A1; sacc += A2; sacc += A3; PIN(sacc); W0; W1; PIN(PW); SBAR(); } while (0)
#define EX(v) __builtin_amdgcn_exp2f(v)
#define GAPB(MF, X, B) do { MF; X[B] = EX(X[B]); X[B + 1] = EX(X[B + 1]); X[B + 2] = EX(X[B + 2]); X[B + 3] = EX(X[B + 3]); PIN(X); SBAR(); } while (0)
#define VRD(i) do { const lds_cptr vq__ = (((i) >> 2) ? vp1 : vp0) + sl_vprev_; vlo[VSL(i)] = vtr(vq__ + ((i) & 3) * 2048); vhi[VSL(i)] = vtr(vq__ + ((i) & 3) * 2048 + 1024); } while (0)
#define KRD(G, j) do { if (G) { kload2(kf, kp0 + sl_next, kq0, j); SBAR(); } } while (0)
#define STEP(C0, C1, P0, P1, t, GK, GV, GL, MASKED) do { SBAR(); \
    const int sl_vprev_ = sl_prev; \
    C0 = MFMA(BFRAG0, bq, ZERO16); C1 = MFMA(BFRAG1, bq, ZERO16); \
    VRD(0); SBAR(); float sacc = (P0[0] + P0[1]); \
    GAPA(C0 = MFMA(kf[0], qr[0], C0), P0[2], P0[3], P0[4], P0[5],     pw0[0] = PKW(P0, 0), pw0[1] = PKW(P0, 2), pw0); \
    VRD(4); SBAR(); GAPA(C1 = MFMA(kf[1], qr[0], C1), P0[6], P0[7], P0[8], P0[9],     pw0[2] = PKW(P0, 4), pw0[3] = PKW(P0, 6), pw0); \
    VRD(1); SBAR(); GAPA(C0 = MFMA(kf[2], qr[1], C0), P0[10], P0[11], P0[12], P0[13], pw1[0] = PKW(P0, 8), pw1[1] = PKW(P0, 10), pw1); \
    VRD(5); SBAR(); GAPA(C1 = MFMA(kf[3], qr[1], C1), P0[14], P0[15], P1[0], P1[1],   pw1[2] = PKW(P0, 12), pw1[3] = PKW(P0, 14), pw1); \
    GAPA(C0 = MFMA(kf[4], qr[2], C0), P1[2], P1[3], P1[4], P1[5],     pw2[0] = PKW(P1, 0), pw2[1] = PKW(P1, 2), pw2); \
    GAPA(C1 = MFMA(kf[5], qr[2], C1), P1[6], P1[7], P1[8], P1[9],     pw2[2] = PKW(P1, 4), pw2[3] = PKW(P1, 6), pw2); \
    GAPA(C0 = MFMA(kf[6], qr[3], C0), P1[10], P1[11], P1[12], P1[13], pw3[0] = PKW(P1, 8), pw3[1] = PKW(P1, 10), pw3); \
    GAPA(C1 = MFMA(kf[7], qr[3], C1), P1[14], P1[15], 0.f, 0.f,       pw3[2] = PKW(P1, 12), pw3[3] = PKW(P1, 14), pw3); \
    l_reg += sacc; \
    if (GK) { DMA_K((t) + 3, sl_cur); } if (GV) { DMA_V((t) + 1, sl_next); } \
    if (MASKED) { const int jb_ = (t) - (NT - 4); if (causal && jb_ >= 0) cmask(C0, C1, jb_, qrel, hi); } \
    float gnx_ = 0.f; if (GL) { gnx_ = *(const ALAS float*)(gl0 + ((t) + 1) * gstep); } \
    SBAR(); \
    GAPB(o[0] = MFMA(PAF(0), VFR(0), o[0]), C0, 0);  VRD(2); SBAR(); \
    GAPB(o[1] = MFMA(PAF(0), VFR(4), o[1]), C0, 4);  VRD(6); SBAR(); \
    KRD(GL, 0); GAPB(o[0] = MFMA(PAF(1), VFR(1), o[0]), C0, 8);  VRD(3); SBAR(); \
    KRD(GL, 1); GAPB(o[1] = MFMA(PAF(1), VFR(5), o[1]), C0, 12); VRD(7); SBAR(); \
    if (GL) { bias_split(Gref - gnx_, bx0, bx1); PIN(bx0); PIN(bx1); SBAR(); } \
    KRD(GL, 2); GAPB(o[0] = MFMA(PAF(2), VFR(2), o[0]), C1, 0); \
    KRD(GL, 3); GAPB(o[1] = MFMA(PAF(2), VFR(6), o[1]), C1, 4); \
    GAPB(o[0] = MFMA(PAF(3), VFR(3), o[0]), C1, 8); \
    GAPB(o[1] = MFMA(PAF(3), VFR(7), o[1]), C1, 12); \
    } while (0)
    int t = 1;
    for (; t + 5 < NT; t += 2) {
        STEP(pB0, pB1, pA0, pA1, t, true, true, true, false);     WAIT_BAR(2); ROT();
        STEP(pA0, pA1, pB0, pB1, t + 1, true, true, true, false); WAIT_BAR(2); ROT();
    }
#define ENDW(tt) do { if ((tt) + 3 < NT) { WAIT_BAR(2); } else if ((tt) + 2 < NT) { WAIT_BAR(1); } else { WAIT_BAR(0); } } while (0)
    unsigned pendq = 0u;
    for (; t + 1 < NT; t += 2) {
        if (t + 3 >= NT && tid == 0 && d.qctr) pendq = __hip_atomic_fetch_add(d.qctr, 1u, __ATOMIC_RELAXED, __HIP_MEMORY_SCOPE_AGENT);
        STEP(pB0, pB1, pA0, pA1, t, (t + 3 < NT), (t + 1 < NT), (t + 1 < NT), true);
        if (t + 3 < NT) { WAIT_BAR(2); } else if (wid == 0 && d.qctr) { WAIT_BAR(2); } else { WAIT_BAR(1); }
        ROT();
        STEP(pA0, pA1, pB0, pB1, t + 1, (t + 4 < NT), (t + 2 < NT), (t + 2 < NT), true);
        if (t + 3 < NT) { ENDW(t + 1); }
        else { asm volatile("s_waitcnt vmcnt(0)" ::: "memory"); if (tid == 0 && d.qctr) *(volatile ALAS unsigned*)(shm3 + d.hookQ) = pendq; asm volatile("s_waitcnt lgkmcnt(0)\n\ts_barrier" ::: "memory"); }
        ROT();
    }
    int le = lane; asm volatile("" : "+v"(le));
    const unsigned gsl = (unsigned)__builtin_amdgcn_readfirstlane((wid < 6) ? LDS_K + wid * 4096 : LDS_V + sl_next + (wid - 6) * 4096);
    { const bf16* gw = d.gate + (long)(wid * QBLK) * d.gpitch; const unsigned gv = (unsigned)((le >> 3) * d.gpitch + (le & 7) * 8) * 2u;
#pragma unroll
      for (int i = 0; i < 4; ++i) glds16s(gw + (long)(8 * i) * d.gpitch, gv, (unsigned)__builtin_amdgcn_readfirstlane(lds0 + gsl + i * 1024)); }
    { unsigned rq = 0xffffffffu; if (d.qctr) rq = (unsigned)__builtin_amdgcn_readfirstlane(*(volatile ALAS unsigned*)(shm3 + d.hookQ));
      const bf16* nq = nextq(rq); DMA_Q(nq ? nq : d.Q); }
    STEP(pB0, pB1, pA0, pA1, NT - 1, false, false, false, true);
    { float sacc = pB0[0] + pB0[1];
#pragma unroll
      for (int r = 2; r < 16; ++r) sacc += pB0[r];
#pragma unroll
      for (int r = 0; r < 16; ++r) sacc += pB1[r];
      l_reg += sacc;
      pw0 = (u32x4){PKW(pB0, 0), PKW(pB0, 2), PKW(pB0, 4), PKW(pB0, 6)}; pw1 = (u32x4){PKW(pB0, 8), PKW(pB0, 10), PKW(pB0, 12), PKW(pB0, 14)};
      pw2 = (u32x4){PKW(pB1, 0), PKW(pB1, 2), PKW(pB1, 4), PKW(pB1, 6)}; pw3 = (u32x4){PKW(pB1, 8), PKW(pB1, 10), PKW(pB1, 12), PKW(pB1, 14)};
      SBAR();
      const int vb0_ = (int)(unsigned)(size_t)(vp0 + sl_cur), vb1_ = (int)(unsigned)(size_t)(vp1 + sl_cur);
#pragma unroll
      for (int d0 = 0; d0 < 2; ++d0) { s16x4 lo[4], hh[4];
#pragma unroll
        for (int ks = 0; ks < 4; ++ks) {
            asm volatile("ds_read_b64_tr_b16 %0,%1 offset:%c2" : "=&v"(lo[ks]) : "v"(d0 ? vb1_ : vb0_), "i"(ks * 2048) : "memory");
            asm volatile("ds_read_b64_tr_b16 %0,%1 offset:%c2" : "=&v"(hh[ks]) : "v"(d0 ? vb1_ : vb0_), "i"(ks * 2048 + 1024) : "memory"); }
        asm volatile("s_waitcnt lgkmcnt(0)" ::: "memory"); SBAR();
#define PK(k) (bf16x8){lo[k][0], lo[k][1], lo[k][2], lo[k][3], hh[k][0], hh[k][1], hh[k][2], hh[k][3]}
        o[d0] = MFMA(PAF(0), PK(0), o[d0]); o[d0] = MFMA(PAF(1), PK(1), o[d0]); o[d0] = MFMA(PAF(2), PK(2), o[d0]); o[d0] = MFMA(PAF(3), PK(3), o[d0]);
#undef PK
      } }
    { auto rr = __builtin_amdgcn_permlane32_swap(__float_as_uint(l_reg), __float_as_uint(l_reg), false, false); l_reg = __uint_as_float(rr[0]) + __uint_as_float(rr[1]); }
    if (hi == 0) wsf[32 + r32] = l_reg; asm volatile("s_waitcnt lgkmcnt(0)" ::: "memory");
    float rli[16];
#pragma unroll
    for (int r = 0; r < 16; ++r) rli[r] = __builtin_amdgcn_rcpf(wsf[32 + crow(r, hi)]);
    { __hip_bfloat16* stg = (__hip_bfloat16*)(shm + LDS_OST) + wid * 2048;
#pragma unroll
      for (int r = 0; r < 16; ++r) { const int orow = crow(r, hi);
#pragma unroll
        for (int d0 = 0; d0 < 2; ++d0) stg[orow * 64 + d0 * 32 + r32] = __float2bfloat16(o[d0][r] * rli[r]); }
      asm volatile("s_waitcnt lgkmcnt(0)" ::: "memory");
      bf16* ow = d.O + (long)(wid * QBLK) * d.opitch;
      asm volatile("s_waitcnt vmcnt(4)" ::: "memory");
#pragma unroll
      for (int i = 0; i < 4; ++i) { const int row = i * 8 + (le >> 3), ch = le & 7; const u32x4 v = *(const u32x4*)(stg + row * 64 + ch * 8);
        const u32x4 g = *(const ALAS u32x4*)(shm3 + gsl + i * 1024 + le * 16);
        u32x4 w; w.x = mul_bf16x2(v.x, g.x); w.y = mul_bf16x2(v.y, g.y); w.z = mul_bf16x2(v.z, g.z); w.w = mul_bf16x2(v.w, g.w);
        if (d.wt) st16_wt(ow + (long)row * d.opitch + ch * 8, w); else *(u32x4*)(ow + (long)row * d.opitch + ch * 8) = w; } }
    asm volatile("s_waitcnt lgkmcnt(0)\n\ts_barrier" ::: "memory");
#undef DMA_K
#undef DMA_Q
#undef Q_AND_BIAS
#undef DMA_V
#undef ROT
#undef MFMA
#undef PKW
#undef PAF
#undef VFR
#undef PIN
#undef GAPA
#undef GAPB
#undef EX
#undef VRD
#undef KRD
#undef STEP
#undef BFRAG0
#undef BFRAG1
#undef ZERO16
#undef ENDW
}
#undef SBAR
#undef WAIT_BAR
}


constexpr int NWAVES = 8;
#ifndef MK_N_LAUNCHES
#define MK_N_LAUNCHES 1
#endif
constexpr int N_LAUNCHES = MK_N_LAUNCHES;
constexpr int N_PHASES = 4;
#ifndef PROBE_REP
#define PROBE_REP -1
#endif
#ifndef PROBE_MODE
#define PROBE_MODE -1
#endif
#ifndef PROBE_PREFIX
#define PROBE_PREFIX 0
#endif
#ifndef PROBE_FUSED
#define PROBE_FUSED -1
#endif
#ifndef PROBE_P1
#define PROBE_P1 -1
#endif
#ifndef FUSE23
#define FUSE23 ((MK_N_LAUNCHES == 1) && (PROBE_PREFIX == 0))
#endif

constexpr int BATCH = 8, SEQ = 4096, DMODEL = 1024, MROWS = BATCH * SEQ;
constexpr int INW = 3080;
constexpr int NPJ = 3072;
constexpr int C_UA = 0, C_GA = 256, C_QB = 512, C_KB = 1024, C_VB = 1536, C_GB = 2048, C_QM = 2560, C_GM = 2816;
constexpr int NMEM = 256, MEMROWS = BATCH * NMEM, MEMW = 256;
constexpr int FOXH = 8, MEMH = 4;
constexpr float EPS = 1e-6f, LOG2E = 1.4426950408889634f, C2 = 0.125f * 1.4426950408889634f;

constexpr size_t MiB = 1u << 20;
constexpr size_t WS_CTL = 0, CTL_ZERO_BYTES = 131072;
constexpr size_t WS_WIN = 1 * MiB;
constexpr size_t WS_WO = 8 * MiB;
constexpr size_t WS_WKV = 10 * MiB;
constexpr size_t WS_WP = 11 * MiB;
constexpr size_t WS_MN = 12 * MiB;
constexpr size_t WS_KM = 16 * MiB;
constexpr size_t WS_VM = 17 * MiB;
constexpr size_t WS_GLOC = 18 * MiB;
constexpr size_t WS_T = 19 * MiB;
constexpr size_t WS_G = 20 * MiB;
constexpr size_t WS_XN = 32 * MiB;
constexpr size_t WS_PJ = 96 * MiB;
constexpr size_t WS_MIX = 288 * MiB;
constexpr size_t WS_DUMMY = 352 * MiB;
constexpr size_t WS_DUMMY2 = 384 * MiB;
constexpr size_t WS_END = 512 * MiB;
constexpr int CW_BAR = 1024;
constexpr int CW_QUEUE = 8192;
constexpr int CW_READY = 15872, CW_CLAIM = CW_READY + 128;
constexpr unsigned PANEL_NEED = 14u;
#ifndef GEMM_STAGGER_US
#define GEMM_STAGGER_US 0
#endif
#ifndef GEMM_QUOTA
#define GEMM_QUOTA 0
#endif
constexpr size_t WS_T0 = 21 * MiB;
constexpr int NFOXU = BATCH * FOXH * (SEQ / 256), NMEMU = BATCH * MEMH * (SEQ / 256), NPOOLU = MROWS / 128, NUNITS = NFOXU + NMEMU + NPOOLU;
constexpr float PRUNE_LOG2 = 32.0f;

constexpr int RING_BYTES = 151552, LDSCTL_OFF = RING_BYTES, MISC_OFF = LDSCTL_OFF + 320, LDS_BYTES = 155648;
static_assert(attn::LDS_BYTES <= attn::LDS_GZ && pg8::STAGE_BYTES <= attn::LDS_GZ && attn::LDS_GZ + 1024 + 4096 <= RING_BYTES, "phase scratch fits the phase region");

#define GAS __attribute__((address_space(1)))
#define LAS __attribute__((address_space(3)))
typedef unsigned short bf16;
typedef unsigned v4u __attribute__((ext_vector_type(4)));
typedef unsigned v2u __attribute__((ext_vector_type(2)));
typedef float f32x4 __attribute__((ext_vector_type(4)));
typedef short bf16x8 __attribute__((ext_vector_type(8)));
typedef GAS unsigned gu32;
#define RLX_AGENT __ATOMIC_RELAXED, __HIP_MEMORY_SCOPE_AGENT
#define LDS_WAIT() asm volatile("s_waitcnt lgkmcnt(0)" ::: "memory")
__device__ __forceinline__ unsigned f2bf(float f) { unsigned u = __builtin_bit_cast(unsigned, f); return (u + 0x7fffu + ((u >> 16) & 1u)) >> 16; }
__device__ __forceinline__ unsigned pk2(float lo, float hi) { return f2bf(lo) | (f2bf(hi) << 16); }
__device__ __forceinline__ float bf2f(unsigned short b) { return __uint_as_float((unsigned)b << 16); }

#define XB_TMO      128
#define XB_XCNT(j)  (256  + 64 * (j))
#define XB_XSUB(j)  (1280 + 64 * (j))
#define XB_XGEN(j)  (2304 + 64 * (j))
#define XB_TOP      3328
#define XB_TOPGEN   3392
#define XCD_BAR_WORDS 3456
#define XB_SPIN_CAP (1u << 18)

__device__ __forceinline__ unsigned xb_ld(unsigned* p)              { return __hip_atomic_load(p, __ATOMIC_RELAXED, __HIP_MEMORY_SCOPE_AGENT); }
__device__ __forceinline__ unsigned xb_add(unsigned* p, unsigned v) { return __hip_atomic_fetch_add(p, v, __ATOMIC_RELAXED, __HIP_MEMORY_SCOPE_AGENT); }
__device__ __forceinline__ unsigned xb_xcc_id() { return (unsigned)__builtin_amdgcn_s_getreg((3 << 11) | 20) & 0xFu; }
#define XB_SPIN(cond, bar) do { unsigned _sp = 0; while (cond) { __builtin_amdgcn_s_sleep(1); \
    if ((++_sp & 255u) == 0u) { if (xb_ld(&(bar)[XB_TMO])) break; if (_sp > XB_SPIN_CAP) { atomicAdd(&(bar)[XB_TMO], 1u); break; } } } } while (0)

struct XcdBarrier {
    unsigned* bar; unsigned x;
    volatile LAS unsigned* st;
};

__device__ __forceinline__ XcdBarrier xcd_barrier_post(unsigned* bar, volatile LAS unsigned* st) {
    XcdBarrier b; b.bar = bar; b.x = xb_xcc_id(); b.st = st;
    if (threadIdx.x == 0) (void)xb_add(&bar[XB_XCNT(b.x)], 1u);
    return b;
}
__device__ __forceinline__ void xcd_barrier_complete(unsigned* bar, unsigned x, unsigned& nloc, unsigned& nx) {
    const unsigned G = gridDim.x * gridDim.y * gridDim.z;
    unsigned sum, cnt, mine, sp = 0u;
    for (;;) {
        sum = 0u; cnt = 0u; mine = 0u;
#pragma unroll
        for (unsigned j = 0; j < 16; ++j) { const unsigned c = xb_ld(&bar[XB_XCNT(j)]); sum += c; cnt += (c > 0u) ? 1u : 0u; mine = (j == x) ? c : mine; }
        if (sum == G) break;
        __builtin_amdgcn_s_sleep(1);
        if ((++sp & 255u) == 0u) { if (xb_ld(&bar[XB_TMO])) break; if (sp > XB_SPIN_CAP) { atomicAdd(&bar[XB_TMO], 1u); break; } }
    }
    nloc = mine > 0u ? mine : 1u; nx = cnt > 0u ? cnt : 1u;
}

__device__ __forceinline__ void xcd_barrier(const XcdBarrier& b) {
    asm volatile("s_waitcnt vmcnt(0)" ::: "memory");
    __syncthreads();
    if (threadIdx.x == 0) {
        unsigned* bar = b.bar;
        __builtin_amdgcn_s_waitcnt(0);
        unsigned nloc = b.st[0], nx = b.st[1];
        if (nloc == 0u) { xcd_barrier_complete(bar, b.x, nloc, nx); b.st[0] = nloc; b.st[1] = nx; }
        const unsigned old = xb_add(&bar[XB_XSUB(b.x)], 1u);
        const unsigned gen = old / nloc;
        if (old + 1u == (gen + 1u) * nloc) {
            __builtin_amdgcn_fence(__ATOMIC_RELEASE, "agent");
            asm volatile("s_waitcnt vmcnt(0)" ::: "memory");
            const unsigned og = xb_add(&bar[XB_TOP], 1u);
            const unsigned tg = og / nx;
            if (og + 1u == (tg + 1u) * nx) xb_add(&bar[XB_TOPGEN], 1u);
            else XB_SPIN(xb_ld(&bar[XB_TOPGEN]) == tg, bar);
            __builtin_amdgcn_fence(__ATOMIC_ACQUIRE, "agent");
            xb_add(&bar[XB_XGEN(b.x)], 1u);
            asm volatile("s_waitcnt vmcnt(0)" ::: "memory");
        } else {
            XB_SPIN(xb_ld(&bar[XB_XGEN(b.x)]) == gen, bar);
            __builtin_amdgcn_fence(__ATOMIC_ACQUIRE, "agent");
            asm volatile("s_waitcnt vmcnt(0)" ::: "memory");
        }
    }
    __syncthreads();
}


__device__ __forceinline__ float dpp_f(float v, int ctrl_sel) {
    const int x = __builtin_bit_cast(int, v); int r;
    switch (ctrl_sel) { case 0: r = __builtin_amdgcn_update_dpp(0, x, 0xB1, 0xF, 0xF, true); break;
                        case 1: r = __builtin_amdgcn_update_dpp(0, x, 0x4E, 0xF, 0xF, true); break;
                        case 2: r = __builtin_amdgcn_update_dpp(0, x, 0x141, 0xF, 0xF, true); break;
                        default: r = __builtin_amdgcn_update_dpp(0, x, 0x140, 0xF, 0xF, true); break; }
    return __builtin_bit_cast(float, r);
}
__device__ __forceinline__ float row16_sum(float v) { v += dpp_f(v, 0); v += dpp_f(v, 1); v += dpp_f(v, 2); v += dpp_f(v, 3); return v; }
__device__ __forceinline__ float rows4_sum(float v) {
    const int x = __builtin_bit_cast(int, v);
    return (__builtin_bit_cast(float, __builtin_amdgcn_readlane(x, 0)) + __builtin_bit_cast(float, __builtin_amdgcn_readlane(x, 16))) +
           (__builtin_bit_cast(float, __builtin_amdgcn_readlane(x, 32)) + __builtin_bit_cast(float, __builtin_amdgcn_readlane(x, 48)));
}
__device__ __forceinline__ float wave_sum(float v) { return rows4_sum(row16_sum(v)); }
__device__ __forceinline__ float wave_max(float v) {
#pragma unroll
    for (int o = 1; o < 64; o <<= 1) v = fmaxf(v, __shfl_xor(v, o));
    return v;
}
__device__ __forceinline__ void transpose_item(const float* W, int ldw, int n0s, bf16* WT, int ldt, int n0d, int k0, LAS float* scr, int lane) {
    float tv[32];
#pragma unroll
    for (int i = 0; i < 32; ++i) tv[i] = W[(size_t)(k0 + 2 * i + (lane >> 5)) * ldw + n0s + (lane & 31)];
#pragma unroll
    for (int i = 0; i < 32; ++i) scr[(2 * i + (lane >> 5)) * 33 + (lane & 31)] = tv[i];
    LDS_WAIT(); asm volatile("" ::: "memory");
    const int c = lane & 7;
#pragma unroll
    for (int j = 0; j < 4; ++j) { const int n = (lane >> 3) + 8 * j; const LAS float* s = scr + (8 * c) * 33 + n;
        v4u o; o.x = pk2(s[0 * 33], s[1 * 33]); o.y = pk2(s[2 * 33], s[3 * 33]); o.z = pk2(s[4 * 33], s[5 * 33]); o.w = pk2(s[6 * 33], s[7 * 33]);
        *(GAS v4u*)(WT + (size_t)(n0d + n) * ldt + k0 + 8 * c) = o; }
    LDS_WAIT(); asm volatile("" ::: "memory");
}

__device__ __forceinline__ float logit_bound(const float* ga, const float* gb, int lane) {
    const float v = wave_max(fabsf(ga[lane] * gb[lane]));
    return __uint_as_float(__builtin_amdgcn_readfirstlane(__float_as_uint(8.0f * LOG2E * v * 1.02f + 0.5f)));
}
struct Args { const float* in[14]; float* out; unsigned char* ws; int ph_lo, ph_hi; int ulo, uhi, qw, sub; int pmode, li; };

__device__ __forceinline__ void phase0(const Args& a, LAS unsigned char* lds, int tid, int lane, int wave) {
    const int blk = blockIdx.x, G = gridDim.x;
    unsigned char* ws = a.ws;
    const float* x = a.in[0]; const float* mem = a.in[1]; const float* norm_g = a.in[2]; const float* w_in = a.in[3]; const float* b_f = a.in[4];
    const float* w_pool = a.in[5]; const float* pool_scale = a.in[6]; const float* mem_norm_g = a.in[9]; const float* w_mem_kv = a.in[10]; const float* w_out = a.in[13];
    LAS float* WfT = (LAS float*)lds;
    LAS float* lf = (LAS float*)(lds + 32768);
    LAS float* scr = (LAS float*)(lds + 40960 + wave * 8448);
    { float wv[16];
#pragma unroll
      for (int q = 0; q < 16; ++q) { const int idx = tid + 512 * q; wv[q] = w_in[(size_t)(idx >> 3) * INW + 2048 + (idx & 7)]; }
#pragma unroll
      for (int q = 0; q < 16; ++q) { const int idx = tid + 512 * q; WfT[(idx & 7) * 1024 + (idx >> 3)] = wv[q]; } }
    { const int gt = blk * 512 + tid; if (gt < 16384) { const int g = gt >> 12, e = (gt >> 6) & 63, c = gt & 63;
        ((bf16*)(ws + WS_WP))[gt] = (bf16)f2bf(w_pool[g * 4096 + c * 64 + e] * pool_scale[g * 64 + e]); } }
    { const int gw = blk * NWAVES + wave, NGW = G * NWAVES;
      constexpr int I_IN = 96 * 16, I_O = 32 * 16, I_KV = 16 * 16;
      for (int it = gw; it < I_IN + I_O + I_KV; it += NGW) {
          int r = it;
          if (r < I_IN) { const int lbg = r % 96, kb = r / 96; const int j0 = 32 * lbg, n0s = j0 + (j0 >= 2048 ? 8 : 0);
              const int pn = j0 >> 8, lb = (j0 & 255) >> 5, pb = 4 * (lb & 1) + (lb >> 1);
              transpose_item(w_in, INW, n0s, (bf16*)(ws + WS_WIN), DMODEL, 256 * pn + 32 * pb, 64 * kb, scr, lane); continue; }
          r -= I_IN;
          if (r < I_O) { const int nb = r % 32, kb = r / 32; transpose_item(w_out, DMODEL, 32 * nb, (bf16*)(ws + WS_WO), DMODEL, 32 * nb, 64 * kb, scr, lane); continue; }
          r -= I_O;
          { const int nb = r % 16, kb = r / 16; transpose_item(w_mem_kv, 512, 32 * nb, (bf16*)(ws + WS_WKV), DMODEL, 32 * nb, 64 * kb, scr, lane); }
      } }
    __syncthreads();
    f32x4 gn[4];
#pragma unroll
    for (int j = 0; j < 4; ++j) gn[j] = ((const f32x4*)norm_g)[lane + 64 * j];
    for (int rb = blk; rb * 128 < MROWS; rb += G) {
        f32x4 vn[4];
        { const GAS f32x4* xr = (const GAS f32x4*)(x + ((size_t)rb * 128 + 16 * wave) * DMODEL) + lane;
#pragma unroll
          for (int j = 0; j < 4; ++j) vn[j] = xr[64 * j]; }
        for (int i = 0; i < 16; ++i) {
            const int rl = 16 * wave + i; const size_t row = (size_t)rb * 128 + rl;
            f32x4 v[4]; float ss = 0.f;
#pragma unroll
            for (int j = 0; j < 4; ++j) { v[j] = vn[j]; ss = fmaf(v[j].x, v[j].x, ss); ss = fmaf(v[j].y, v[j].y, ss); ss = fmaf(v[j].z, v[j].z, ss); ss = fmaf(v[j].w, v[j].w, ss); }
            if (i < 15) { const GAS f32x4* xr = (const GAS f32x4*)(x + (row + 1) * DMODEL) + lane;
#pragma unroll
                for (int j = 0; j < 4; ++j) vn[j] = xr[64 * j]; }
            const float rstd = 1.0f / sqrtf(wave_sum(ss) * (1.0f / DMODEL) + EPS);
#pragma unroll
            for (int j = 0; j < 4; ++j) v[j] = v[j] * rstd * gn[j];
            GAS v2u* o8 = (GAS v2u*)((bf16*)(ws + WS_XN) + row * DMODEL) + lane;
#pragma unroll
            for (int j = 0; j < 4; ++j) { v2u w; w.x = attn::cvtpk_s(v[j].x, v[j].y); w.y = attn::cvtpk_s(v[j].z, v[j].w); o8[64 * j] = w; }
            float pj[8];
#pragma unroll
            for (int jj = 0; jj < 8; ++jj) { float p = 0.f;
#pragma unroll
                for (int j = 0; j < 4; ++j) { const f32x4 w = *(const LAS f32x4*)(WfT + jj * 1024 + 4 * lane + 256 * j); p = fmaf(v[j].x, w.x, p); p = fmaf(v[j].y, w.y, p); p = fmaf(v[j].z, w.z, p); p = fmaf(v[j].w, w.w, p); }
                pj[jj] = row16_sum(p); }
            float fz = 0.f;
#pragma unroll
            for (int jj = 0; jj < 8; ++jj) { const float t = rows4_sum(pj[jj]); if (lane == jj) fz = t; }
            if (lane < 8) { const float z = fz + b_f[lane]; lf[rl * 8 + lane] = fminf(z, 0.f) - log1pf(expf(-fabsf(z))); }
        }
        __syncthreads();
        { const int h = wave; const float p0 = lf[(2 * lane) * 8 + h], p1 = lf[(2 * lane + 1) * 8 + h]; const float s = p0 + p1; float inc = s;
#pragma unroll
          for (int o = 1; o < 64; o <<= 1) { const float t = __shfl_up(inc, o); if (lane >= o) inc += t; }
          const float exc = inc - s; float* gl = (float*)(ws + WS_GLOC) + ((size_t)rb * 128) * 8;
          gl[(2 * lane) * 8 + h] = exc + p0; gl[(2 * lane + 1) * 8 + h] = exc + p0 + p1;
          if (lane == 63) ((float*)(ws + WS_T))[rb * 8 + h] = inc; }
        __syncthreads();
    }
#pragma unroll
    for (int j = 0; j < 4; ++j) gn[j] = ((const f32x4*)mem_norm_g)[lane + 64 * j];
    for (int row = blk * NWAVES + wave; row < MEMROWS; row += G * NWAVES) {
        const GAS f32x4* xr = (const GAS f32x4*)(mem + (size_t)row * DMODEL) + lane;
        f32x4 v[4]; float ss = 0.f;
#pragma unroll
        for (int j = 0; j < 4; ++j) { v[j] = xr[64 * j]; ss += (v[j].x * v[j].x + v[j].y * v[j].y) + (v[j].z * v[j].z + v[j].w * v[j].w); }
        const float rstd = 1.0f / sqrtf(wave_sum(ss) * (1.0f / DMODEL) + EPS);
        GAS v2u* o8 = (GAS v2u*)((bf16*)(ws + WS_MN) + (size_t)row * DMODEL) + lane;
#pragma unroll
        for (int j = 0; j < 4; ++j) { const f32x4 y = v[j] * rstd * gn[j]; v2u w; w.x = pk2(y.x, y.y); w.y = pk2(y.z, y.w); o8[64 * j] = w; }
    }
}

__device__ __forceinline__ void phase1_pre(const Args& a, LAS unsigned char* lds, int tid, int lane, int wave) {
    unsigned char* ws = a.ws; const int G = gridDim.x;
    LAS float* red = (LAS float*)lds;
    LAS float* offs = (LAS float*)(lds + 1024);
    for (int rb = blockIdx.x; rb * 128 < MROWS; rb += G) {
        const int b = rb >> 5;
        if (tid < 256) { const int cr = tid >> 3, h = tid & 7, cb = 32 * b + cr; red[tid] = (cb < rb) ? ((const float*)(ws + WS_T))[cb * 8 + h] : 0.f; }
        __syncthreads();
        if (tid < 8) { float s = 0.f; for (int cr = 0; cr < 32; ++cr) s += red[cr * 8 + tid]; offs[tid] = s; }
        __syncthreads();
        for (int e = tid; e < 1024; e += 512) { const int r = e >> 3, h = e & 7;
            ((float*)(ws + WS_G))[(size_t)(b * 8 + h) * SEQ + 128 * (rb & 31) + r] = (((const float*)(ws + WS_GLOC))[((size_t)rb * 128 + r) * 8 + h] + offs[h]) * LOG2E; }
        __syncthreads();
    }
    if (wave >= 4) {
        const float Bf = logit_bound(a.in[7], a.in[8], lane); const float thr = -(PRUNE_LOG2 + 2.0f * Bf);
        for (int u = blockIdx.x * 4 + (wave - 4); u < NFOXU; u += G * 4) {
            const int bh = u >> 4, qb = u & 15, b = bh >> 3, h = bh & 7;
            const float tv = (lane < 32) ? ((const float*)(ws + WS_T))[(32 * b + lane) * 8 + h] : 0.f; float inc = tv;
#pragma unroll
            for (int o = 1; o < 32; o <<= 1) { const float t = __shfl_up(inc, o); if (lane >= o) inc += t; }
            const float exc = inc - tv;
            const float* gl = (const float*)(ws + WS_GLOC) + (size_t)b * SEQ * 8 + h;
            const int q0 = 256 * qb, sk = 64 * lane + 63;
            const float gq = (gl[(size_t)q0 * 8] + __shfl(exc, q0 >> 7)) * LOG2E;
            const float gs = (gl[(size_t)sk * 8] + __shfl(exc, sk >> 7)) * LOG2E;
            const unsigned long long m = __ballot(lane < 4 * qb && (gq - gs) < thr);
            if (lane == 0) ((int*)(ws + WS_T0))[u] = (int)__popcll(m) & ~1;
        }
    }
    const float* mem_k_g = a.in[12];
    __syncthreads();
    for (int u = blockIdx.x; u < 32 * 8; u += G) {
        const int rt = u >> 3, ct = u & 7; const int fr = lane & 15, fq = lane >> 4; const int wr4 = wave & 3, wc2 = wave >> 2;
        constexpr int MP = 1040;
        f32x4 acc[2]; acc[0] = (f32x4){0.f, 0.f, 0.f, 0.f}; acc[1] = acc[0];
        for (int half = 0; half < 2; ++half) {
            v4u ta[8], tb[8];
#pragma unroll
            for (int q = 0; q < 8; ++q) { const int c = tid + 512 * q, row = c >> 6, c16 = c & 63;
                ta[q] = *(const GAS v4u*)((const bf16*)(ws + WS_MN) + (size_t)(64 * rt + row) * DMODEL + 512 * half + 8 * c16);
                tb[q] = *(const GAS v4u*)((const bf16*)(ws + WS_WKV) + (size_t)(64 * ct + row) * DMODEL + 512 * half + 8 * c16); }
#pragma unroll
            for (int q = 0; q < 8; ++q) { const int c = tid + 512 * q, row = c >> 6, c16 = c & 63;
                *(LAS v4u*)(lds + row * MP + 16 * c16) = ta[q]; *(LAS v4u*)(lds + 64 * MP + row * MP + 16 * c16) = tb[q]; }
            __syncthreads();
#pragma unroll 4
            for (int ks = 0; ks < 16; ++ks) { const bf16x8 af = *(const LAS bf16x8*)(lds + (16 * wr4 + fr) * MP + 64 * ks + 16 * fq);
#pragma unroll
                for (int nb = 0; nb < 2; ++nb) { const bf16x8 bfr = *(const LAS bf16x8*)(lds + 64 * MP + (32 * wc2 + 16 * nb + fr) * MP + 64 * ks + 16 * fq);
                    acc[nb] = __builtin_amdgcn_mfma_f32_16x16x32_bf16(af, bfr, acc[nb], 0, 0, 0); } }
            __syncthreads();
        }
        LAS float* xs = (LAS float*)(lds + 128 * MP);
        float ssr[4];
#pragma unroll
        for (int reg = 0; reg < 4; ++reg) { float ss = acc[0][reg] * acc[0][reg] + acc[1][reg] * acc[1][reg];
            ss += __shfl_xor(ss, 1); ss += __shfl_xor(ss, 2); ss += __shfl_xor(ss, 4); ss += __shfl_xor(ss, 8); ssr[reg] = ss;
            if (fr == 0) xs[wc2 * 64 + 16 * wr4 + 4 * fq + reg] = ss; }
        __syncthreads();
        if (ct < 4) {
#pragma unroll
            for (int reg = 0; reg < 4; ++reg) { const int row = 16 * wr4 + 4 * fq + reg; const float r = 1.0f / sqrtf((ssr[reg] + xs[(wc2 ^ 1) * 64 + row]) * (1.0f / 64.0f) + EPS);
                bf16* o = (bf16*)(ws + WS_KM) + (size_t)(64 * rt + row) * MEMW + 64 * ct + 32 * wc2;
#pragma unroll
                for (int nb = 0; nb < 2; ++nb) o[16 * nb + fr] = (bf16)f2bf(acc[nb][reg] * r * mem_k_g[32 * wc2 + 16 * nb + fr]); }
        } else {
#pragma unroll
            for (int reg = 0; reg < 4; ++reg) { bf16* o = (bf16*)(ws + WS_VM) + (size_t)(64 * rt + 16 * wr4 + 4 * fq + reg) * MEMW + 64 * (ct - 4) + 32 * wc2;
#pragma unroll
                for (int nb = 0; nb < 2; ++nb) o[16 * nb + fr] = (bf16)f2bf(acc[nb][reg]); }
        }
        __syncthreads();
    }
    __syncthreads();
}

constexpr int DL_PITCH = 264, UB_OFF = 0, DL_OFF = 144 * 512, POOL_LDS = DL_OFF + 128 * DL_PITCH * 2;
__device__ __forceinline__ unsigned mulbf2(unsigned a, unsigned b) { return pk2(__uint_as_float(a << 16) * __uint_as_float(b << 16), __uint_as_float(a & 0xffff0000u) * __uint_as_float(b & 0xffff0000u)); }
__device__ __forceinline__ void pool_unit(const Args& a, int pu, LAS unsigned char* lds, int tid_, int lane_, int wave, int wt = 0) {
    int tid = tid_; asm volatile("" : "+v"(tid)); const int lane = tid & 63;
    unsigned char* ws = a.ws;
    const bf16* PJ = (const bf16*)(ws + WS_PJ);
    const int r0 = pu * 128, tpos0 = r0 & (SEQ - 1);
    v4u uv[9], gtv[8];
#pragma unroll
    for (int q = 0; q < 9; ++q) { const int c = tid + q * NWAVES * 64, row = c >> 5, ch = c & 31; const int tp = tpos0 - 16 + row;
        uv[q] = (v4u){0u, 0u, 0u, 0u}; if (tp >= 0) uv[q] = *(const GAS v4u*)(PJ + (size_t)(r0 - 16 + row) * NPJ + C_UA + ch * 8); }
    bf16x8 bfr[4][2];
    { const int g = wave >> 1, fr = lane & 15, fq = lane >> 4; const bf16* WpT = (const bf16*)(ws + WS_WP) + g * 4096;
#pragma unroll
      for (int cb = 0; cb < 4; ++cb)
#pragma unroll
        for (int ks = 0; ks < 2; ++ks) bfr[cb][ks] = *(const bf16x8*)(WpT + (16 * cb + fr) * 64 + 32 * ks + 8 * fq); }
#pragma unroll
    for (int q = 0; q < 8; ++q) { const int c = tid + q * NWAVES * 64, row = c >> 5, ch = c & 31; gtv[q] = *(const GAS v4u*)(PJ + (size_t)(r0 + row) * NPJ + C_GA + ch * 8); }
#pragma unroll
    for (int q = 0; q < 9; ++q) { const int c = tid + q * NWAVES * 64, row = c >> 5, ch = c & 31; *(LAS v4u*)(lds + UB_OFF + row * 512 + ch * 16) = uv[q]; }
    __syncthreads();
    {
        const int cp = tid & 127, rq = tid >> 7; const int g = cp >> 5, w = 2 << g;
        const LAS unsigned* ub = (const LAS unsigned*)(lds + UB_OFF) + cp;
        LAS unsigned* dl = (LAS unsigned*)(lds + DL_OFF) + cp;
        const int lr0 = 16 + 32 * rq, tq = tpos0 + 32 * rq; const float invw = 1.0f / (float)w;
        float s0 = 0.f, s1 = 0.f;
        for (int k = w - 1; k >= 1; --k) { const unsigned uu = ub[(lr0 - k) * 128]; s0 += __uint_as_float(uu << 16); s1 += __uint_as_float(uu & 0xffff0000u); }
#pragma unroll 4
        for (int i = 0; i < 32; ++i) {
            const unsigned uu = ub[(lr0 + i) * 128], uo = ub[(lr0 + i + 1 - w) * 128];
            const float c0 = __uint_as_float(uu << 16), c1 = __uint_as_float(uu & 0xffff0000u);
            s0 += c0; s1 += c1;
            const int t = tq + i; float m0, m1;
            if (t + 1 < w) { const float cnt = (float)(t + 1); m0 = s0 / cnt; m1 = s1 / cnt; } else { m0 = s0 * invw; m1 = s1 * invw; }
            dl[(32 * rq + i) * (DL_PITCH / 2)] = pk2(m0 - c0, m1 - c1);
            s0 -= __uint_as_float(uo << 16); s1 -= __uint_as_float(uo & 0xffff0000u);
        }
    }
    __syncthreads();
    {
        const int g = wave >> 1, rh = wave & 1, fr = lane & 15, fq = lane >> 4;
        const LAS unsigned char* dlb = (const LAS unsigned char*)(lds + DL_OFF);
        LAS unsigned short* yl = (LAS unsigned short*)(lds + UB_OFF);
#pragma unroll
        for (int rb = 0; rb < 4; ++rb) {
            f32x4 acc[4];
#pragma unroll
            for (int cb = 0; cb < 4; ++cb) acc[cb] = (f32x4){0.f, 0.f, 0.f, 0.f};
#pragma unroll
            for (int ks = 0; ks < 2; ++ks) { const bf16x8 af = *(const LAS bf16x8*)(dlb + (64 * rh + 16 * rb + fr) * (DL_PITCH * 2) + (64 * g + 32 * ks + 8 * fq) * 2);
#pragma unroll
                for (int cb = 0; cb < 4; ++cb) acc[cb] = __builtin_amdgcn_mfma_f32_16x16x32_bf16(af, bfr[cb][ks], acc[cb], 0, 0, 0); }
#pragma unroll
            for (int reg = 0; reg < 4; ++reg)
#pragma unroll
                for (int cb = 0; cb < 4; ++cb) yl[(64 * rh + 16 * rb + 4 * fq + reg) * DL_PITCH + 64 * g + 16 * cb + fr] = (unsigned short)f2bf(acc[cb][reg]);
        }
    }
    __syncthreads();
#pragma unroll
    for (int q = 0; q < 8; ++q) { const int c = tid + q * NWAVES * 64, row = c >> 5, ch = c & 31;
        const v4u y = *(const LAS v4u*)(lds + UB_OFF + row * (DL_PITCH * 2) + ch * 16);
        const v4u gt = gtv[q];
        v4u o; o.x = mulbf2(y.x, gt.x); o.y = mulbf2(y.y, gt.y); o.z = mulbf2(y.z, gt.z); o.w = mulbf2(y.w, gt.w);
        if (wt) attn::st16_wt((bf16*)(ws + WS_MIX) + (size_t)(r0 + row) * DMODEL + ch * 8, __builtin_bit_cast(attn::u32x4, o)); else *(GAS v4u*)((bf16*)(ws + WS_MIX) + (size_t)(r0 + row) * DMODEL + ch * 8) = o; }
    __syncthreads();
}

__global__ void __launch_bounds__(NWAVES * 64, 2) hymba_fwd(Args args) {
    extern __shared__ __attribute__((aligned(16))) unsigned char lds_raw[];
    LAS unsigned char* lds = (LAS unsigned char*)lds_raw;
    volatile LAS unsigned* MISC = (volatile LAS unsigned*)(lds + MISC_OFF);
    const int tid = threadIdx.x, lane = tid & 63, wave = __builtin_amdgcn_readfirstlane(tid >> 6);
    const int G = gridDim.x; const int bx = blockIdx.x; const int vcu = (G % 8 == 0) ? (bx % 8) * (G / 8) + bx / 8 : bx;
    unsigned char* ws = args.ws;
    gu32* ctl = (gu32*)(ws + WS_CTL);
    static_assert(POOL_LDS <= attn::LDS_GZ, "pool scratch fits the phase region");
    for (int u = tid; u < (LDS_BYTES - LDSCTL_OFF) / 4; u += NWAVES * 64) ((LAS unsigned*)(lds + LDSCTL_OFF))[u] = 0u;
    __syncthreads();
    XcdBarrier bar; bar.bar = (unsigned*)(ctl + CW_BAR) + args.li * XCD_BAR_WORDS; bar.x = 0; bar.st = nullptr;
    if (N_LAUNCHES == 1) bar = xcd_barrier_post((unsigned*)(ctl + CW_BAR) + args.li * XCD_BAR_WORDS, MISC + 8);
    const int lo = args.ph_lo, hi = args.ph_hi;
#define IN(k) (lo <= (k) && (k) < hi)
#define BOTH(k) (IN(k) && IN((k) + 1))

    if (IN(0)) { phase0(args, lds, tid, lane, wave); if (BOTH(0)) xcd_barrier(bar); }

    if (IN(1)) {
        const int late1 = __builtin_amdgcn_readfirstlane((bx >> 3) & 1);
        if (!late1) phase1_pre(args, lds, tid, lane, wave);
        if (!(args.sub & 4)) {
        pg8::Gemm g{(const pg8::bf16_t*)(ws + WS_XN), (const pg8::bf16_t*)(ws + WS_WIN), MROWS, NPJ, DMODEL};
        pg8::StaticOrder S; S.init(MROWS, NPJ, G, bx);
        pg8::EpiProj E{(pg8::bf16_t*)(ws + WS_PJ), NPJ, args.in[7], args.in[8], args.in[11], C2, args.pmode == 8 ? 1 : 0, (unsigned)(size_t)(lds + pg8::STAGE_BYTES)};
        static_assert(pg8::STAGE_BYTES + 8 * 2304 <= RING_BYTES, "epilogue staging above the stage buffers");
        pg8::gemm_phase<pg8::EpiProj, pg8::StaticOrder, true, true>(lds, g, S, E);
        }
        if (late1) { __syncthreads(); phase1_pre(args, lds, tid, lane, wave); }
        if (BOTH(1)) xcd_barrier(bar);
    }

    if (IN(2)) {
        __syncthreads();
        for (int u = tid; u < 256; u += NWAVES * 64) ((LAS unsigned*)(lds + attn::LDS_GZ))[u] = 0u;
        const float Bf = logit_bound(args.in[7], args.in[8], lane), Bm = logit_bound(args.in[11], args.in[12], lane);
        __syncthreads();
        const bf16* PJ = (const bf16*)(ws + WS_PJ); bf16* MIX = (bf16*)(ws + WS_MIX);
        volatile LAS unsigned* Q = MISC + 16;
        const unsigned xq = xb_xcc_id() & 7u;
        gu32* qbase = ctl + CW_QUEUE + 512 * args.qw; const gu32* t0tab = (const gu32*)(ws + WS_T0); const unsigned ilo = (unsigned)args.ulo, ilen = (unsigned)(args.uhi - args.ulo);
        constexpr unsigned QEND = 0xffffffffu;
#define FOX_TAB(i) ((((i) & 63) << 4) + 15 - ((i) >> 6))
#define QDECODE(y, i) (((i) < 64u) ? (unsigned)NFOXU + (y) * 64u + (i) : (((((i) - 64u) >> 3) << 6) | (((((y) - (((i) - 64u) & 7u)) & 7u) << 3) | (((i) - 64u) & 7u))))
#define QPOP(dst) do { unsigned r_ = __hip_atomic_fetch_add(qbase + 64 * xq, 1u, RLX_AGENT); unsigned y_ = xq; \
            for (unsigned dy_ = 1; r_ >= ilen && dy_ < 8; ++dy_) { y_ = (xq + dy_) & 7u; r_ = __hip_atomic_fetch_add(qbase + 64 * y_, 1u, RLX_AGENT); } \
            dst = (r_ < ilen) ? QDECODE(y_, ilo + r_) : QEND; } while (0)
        if constexpr (FUSE23) {
            gu32* ready = ctl + CW_READY + 16384 * args.qw; const int pmode = args.pmode; volatile LAS unsigned* SEL = MISC + 32;
            static_assert(NFOXU == 2 * NWAVES * 64, "two table entries per thread");
            const unsigned tv0 = __hip_atomic_load(t0tab + tid, RLX_AGENT), tv1 = __hip_atomic_load(t0tab + tid + NWAVES * 64, RLX_AGENT);
            unsigned r0 = 0u; if (tid == 0 && pmode < 5) r0 = __hip_atomic_fetch_add(qbase + 64 * xq, 1u, RLX_AGENT);
            for (int pu = vcu; pu < NPOOLU; pu += G) { pool_unit(args, pu, lds, tid, lane, wave, 1);
                asm volatile("s_waitcnt vmcnt(0)" ::: "memory"); __syncthreads(); if (tid == 0) __hip_atomic_fetch_add(ready + (pu >> 1), 1u, RLX_AGENT); }
#define OUT_UNIT(o, pm_, pn_) do { const int h_ = (o) >> 8, r_ = (o) & 255, pi_ = r_ >> 2; pn_ = r_ & 3; pm_ = (pi_ >> 3) * 16 + (h_ ? 7 - (pi_ & 7) : 15 - (pi_ & 7)); } while (0)
            int opm = -1; { const int o_ = vcu + (lane & 1) * G; if (tid < 2 && o_ < 512) { int pn_; OUT_UNIT(o_, opm, pn_); } }
            if (tid < 2) SEL[12 + tid] = 0u;
            LAS unsigned* t0l = (LAS unsigned*)(lds + attn::LDS_GZ + 1024);
            t0l[tid] = tv0; t0l[tid + NWAVES * 64] = tv1;
            if (pmode < 5) {
                if (tid == 0) { unsigned r_ = r0, y_ = xq;
                    for (unsigned dy_ = 1; r_ >= ilen && dy_ < 8; ++dy_) { y_ = (xq + dy_) & 7u; r_ = __hip_atomic_fetch_add(qbase + 64 * y_, 1u, RLX_AGENT); }
                    SEL[0] = (r_ < ilen) ? QDECODE(y_, ilo + r_) : QEND; SEL[1] = 0u; }
                __syncthreads();
                auto nextq = [&](unsigned r) -> const bf16* {
                    if (r >= ilen) return nullptr;
                    const unsigned id = QDECODE(xq, ilo + r);
                    if (id < (unsigned)NFOXU) { const int qb = 15 - (int)(id >> 6), bh = (int)(id & 63), b = bh >> 3, h = bh & 7; return PJ + ((size_t)b * SEQ + (size_t)qb * 256) * NPJ + C_QB + h * 64; }
                    const int idx = (int)id - NFOXU; const int b = idx >> 6, hm = (idx >> 4) & 3, qt = idx & 15; return PJ + ((size_t)b * SEQ + (size_t)qt * 256) * NPJ + C_QM + hm * 64; };
                for (;;) {
                    const unsigned cur = SEL[0]; const unsigned qpre = SEL[1];
                    if (cur == QEND) break;
                    int pm_done; attn::Desc d;
                    if (cur < (unsigned)NFOXU) {
                        const int qb = 15 - (int)(cur >> 6), bh = (int)(cur & 63), b = bh >> 3, h = bh & 7; const size_t row0 = (size_t)b * SEQ + (size_t)qb * 256;
                        d.Q = PJ + row0 * NPJ + C_QB + h * 64; d.K = PJ + (size_t)b * SEQ * NPJ + C_KB + h * 64; d.V = PJ + (size_t)b * SEQ * NPJ + C_VB + h * 64;
                        d.gate = PJ + row0 * NPJ + C_GB + h * 64; d.O = MIX + row0 * DMODEL + 256 + h * 64; d.G = (const float*)(ws + WS_G) + (size_t)bh * SEQ;
                        d.kvpitch = NPJ; d.NT = 4 * qb + 4; d.t0 = (int)t0l[FOX_TAB(cur)]; d.causal = 1; d.q0 = qb * 256; d.negB = -Bf; pm_done = b * 16 + qb;
                    } else {
                        const int idx = (int)cur - NFOXU; const int b = idx >> 6, hm = (idx >> 4) & 3, qt = idx & 15; const size_t row0 = (size_t)b * SEQ + (size_t)qt * 256;
                        d.Q = PJ + row0 * NPJ + C_QM + hm * 64; d.K = (const bf16*)(ws + WS_KM) + (size_t)b * NMEM * MEMW + hm * 64; d.V = (const bf16*)(ws + WS_VM) + (size_t)b * NMEM * MEMW + hm * 64;
                        d.gate = PJ + row0 * NPJ + C_GM + hm * 64; d.O = MIX + row0 * DMODEL + 768 + hm * 64; d.G = nullptr;
                        d.kvpitch = MEMW; d.NT = 4; d.t0 = 0; d.causal = 0; d.q0 = 0; d.negB = -Bm; pm_done = b * 16 + qt;
                    }
                    d.qpitch = NPJ; d.gpitch = NPJ; d.opitch = DMODEL; d.wt = 1; d.qpre = (int)qpre; d.dmaprobe = (pmode == 3) ? 1 : 0; d.qctr = (unsigned*)(qbase + 64 * xq); d.hookQ = (unsigned)(MISC_OFF + 96);
                    d.pendA = 0u; d.pendL = 0u; d.hookA = (unsigned)(MISC_OFF + 160); d.hookL = (unsigned)(MISC_OFF + 164);
                    attn::unit(d, (char*)lds_raw, nextq);
                    unsigned orv = 0u; if (opm >= 0) orv = __hip_atomic_load(ready + opm, RLX_AGENT);
                    unsigned qsn = 0xffffffffu; if (tid < 8) qsn = __hip_atomic_load(qbase + 64 * tid, RLX_AGENT);
                    asm volatile("s_waitcnt vmcnt(0)" ::: "memory");
                    if (opm >= 0) SEL[12 + tid] = (orv >= PANEL_NEED) ? 1u : 0u;
                    if (wave == 0) {
                        unsigned r = MISC[24], y = xq; const unsigned pre = (r < ilen) ? 1u : 0u;
                        if (r >= ilen) {
                            unsigned m = (unsigned)(__ballot(qsn < ilen) & 0xffull) & ~(1u << xq);
                            r = 0xffffffffu;
                            while (m) {
                                const unsigned sh = (xq + 1u) & 7u, rot = ((m >> sh) | (m << (8u - sh))) & 0xffu;
                                y = (sh + (unsigned)__builtin_ctz(rot)) & 7u;
                                unsigned c = 0u; if (lane == 0) c = __hip_atomic_fetch_add(qbase + 64 * y, 1u, RLX_AGENT); c = (unsigned)__builtin_amdgcn_readfirstlane(c);
                                if (c < ilen) { r = c; break; }
                                m &= ~(1u << y); }
                        }
                        if (lane == 0) { SEL[1] = pre; SEL[0] = (r < ilen) ? QDECODE(y, ilo + r) : QEND; } }
                    __syncthreads();
                    if (tid == 0) __hip_atomic_fetch_add(ready + pm_done, 1u, RLX_AGENT);
                }
            }
            if (pmode != 4 && pmode != 3) {
            __syncthreads();
            if (wave == 0) {
                if (pmode >= 5 && lane < 2) SEL[12 + lane] = 1u;
                __builtin_amdgcn_fence(__ATOMIC_ACQUIRE, "agent"); asm volatile("s_waitcnt vmcnt(0)" ::: "memory");
            }
            int it = 0;
            for (int o = vcu; o < 512; o += G, ++it) {
                int pm, pn; OUT_UNIT(o, pm, pn);
                __syncthreads();
                if (wave == 0 && !(it < 2 && SEL[12 + it] != 0u)) {
                    for (unsigned spin = 0; spin < (1u << 16); ++spin) {
                        if (__hip_atomic_load(ready + pm, RLX_AGENT) >= PANEL_NEED || pmode >= 5) break;
                        __builtin_amdgcn_s_sleep(32); }
                    __builtin_amdgcn_fence(__ATOMIC_ACQUIRE, "agent"); asm volatile("s_waitcnt vmcnt(0)" ::: "memory");
                }
                __syncthreads();
                pg8::Gemm g{(const pg8::bf16_t*)(ws + WS_MIX), (const pg8::bf16_t*)(ws + WS_WO), MROWS, DMODEL, DMODEL};
                pg8::OneUnit S{pm, pn};
                pg8::EpiResLds E{args.in[0], (args.pmode >= 5) ? (float*)(ws + WS_DUMMY2) : args.out, DMODEL, (args.pmode == 6) ? 1 : (args.pmode == 7) ? 2 : 0};
                pg8::gemm_phase<pg8::EpiResLds, pg8::OneUnit, false, true>(lds, g, S, E);
            }
            }
        } else {
        if (args.sub & 1) {
        if (tid == 0) { unsigned u0, u1; QPOP(u0); QPOP(u1);
            Q[0] = u0; Q[1] = (u0 < (unsigned)NFOXU) ? __hip_atomic_load(t0tab + FOX_TAB(u0), RLX_AGENT) : 0u; Q[2] = u1; Q[3] = 0u; }
        __syncthreads();
        for (int k = 0;; ++k) {
            const unsigned cur = Q[2 * (k & 1)], ct0 = Q[2 * (k & 1) + 1], nxt = Q[2 * ((k + 1) & 1)];
            if (cur == QEND) break;
            unsigned pa = 0u, pl = 0u;
            if (tid == 0) { pa = __hip_atomic_fetch_add(qbase + 64 * xq, 1u, RLX_AGENT); if (nxt < (unsigned)NFOXU) pl = __hip_atomic_load(t0tab + FOX_TAB(nxt), RLX_AGENT); }
            const unsigned hookA = (unsigned)(MISC_OFF + 96), hookL = (unsigned)(MISC_OFF + 64 + 8 * ((k + 1) & 1) + 4);
            {
                attn::Desc d;
                if (cur < (unsigned)NFOXU) {
                    const int qb = 15 - (int)(cur >> 6), bh = (int)(cur & 63), b = bh >> 3, h = bh & 7; const size_t row0 = (size_t)b * SEQ + (size_t)qb * 256;
                    d.Q = PJ + row0 * NPJ + C_QB + h * 64; d.K = PJ + (size_t)b * SEQ * NPJ + C_KB + h * 64; d.V = PJ + (size_t)b * SEQ * NPJ + C_VB + h * 64;
                    d.gate = PJ + row0 * NPJ + C_GB + h * 64; d.O = MIX + row0 * DMODEL + 256 + h * 64; d.G = (const float*)(ws + WS_G) + (size_t)bh * SEQ;
                    d.kvpitch = NPJ; d.NT = 4 * qb + 4; d.t0 = (int)ct0; d.causal = 1; d.q0 = qb * 256; d.negB = -Bf;
                    if (args.pmode) { d.O = (bf16*)(ws + WS_DUMMY) + row0 * DMODEL + 256 + h * 64; if (args.pmode == 1) d.t0 = 0; if (args.pmode == 2) d.t0 = d.NT - 4; }
                } else {
                    const int idx = (int)cur - NFOXU; const int b = idx >> 6, hm = (idx >> 4) & 3, qt = idx & 15; const size_t row0 = (size_t)b * SEQ + (size_t)qt * 256;
                    d.Q = PJ + row0 * NPJ + C_QM + hm * 64; d.K = (const bf16*)(ws + WS_KM) + (size_t)b * NMEM * MEMW + hm * 64; d.V = (const bf16*)(ws + WS_VM) + (size_t)b * NMEM * MEMW + hm * 64;
                    d.gate = PJ + row0 * NPJ + C_GM + hm * 64; d.O = MIX + row0 * DMODEL + 768 + hm * 64; d.G = nullptr;
                    d.kvpitch = MEMW; d.NT = 4; d.t0 = 0; d.causal = 0; d.q0 = 0; d.negB = -Bm;
                }
                d.qpitch = NPJ; d.gpitch = NPJ; d.opitch = DMODEL; d.wt = 0; d.qpre = 0; d.dmaprobe = 0; d.qctr = nullptr; d.hookQ = 0u; d.pendA = pa; d.pendL = pl; d.hookA = hookA; d.hookL = hookL;
                attn::unit(d, (char*)lds_raw, [](unsigned) -> const bf16* { return nullptr; });
            }
            if (tid == 0) {
                unsigned r = MISC[24], y = xq;
                for (unsigned dy = 1; r >= ilen && dy < 8; ++dy) { y = (xq + dy) & 7u; r = __hip_atomic_fetch_add(qbase + 64 * y, 1u, RLX_AGENT); }
                Q[2 * (k & 1)] = (r < ilen) ? QDECODE(y, ilo + r) : QEND; }
            __syncthreads();
        }
        }
        __syncthreads();
        if (args.sub & 2) for (int pu = vcu; pu < NPOOLU; pu += G) pool_unit(args, pu, lds, tid, lane, wave);
        if (BOTH(2)) xcd_barrier(bar);
        }
#undef QPOP
#undef QDECODE
#undef FOX_TAB
    }

    if (!FUSE23 && IN(3)) {
        __syncthreads();
        pg8::Gemm g{(const pg8::bf16_t*)(ws + WS_MIX), (const pg8::bf16_t*)(ws + WS_WO), MROWS, DMODEL, DMODEL};
        pg8::StaticOrder S; S.init(MROWS, DMODEL, G, bx);
        pg8::EpiRes E{args.in[0], (args.pmode >= 5) ? (float*)(ws + WS_DUMMY2) : args.out, DMODEL, (args.pmode == 6) ? 1 : (args.pmode == 7) ? 2 : 0};
        pg8::gemm_phase<pg8::EpiRes, pg8::StaticOrder, true, true>(lds, g, S, E);
    }
#undef IN
#undef BOTH
}

extern "C" void kernel_launch(void* const* d_in, const int* in_sizes, int n_in, void* d_out, int out_size, void* d_ws, size_t ws_size, hipStream_t stream) {
    static int grid = 0;
    if (grid == 0) {
        if (n_in != 14 || in_sizes[0] != MROWS * DMODEL || out_size != MROWS * DMODEL || ws_size < WS_END) { fprintf(stderr, "kernel_launch: unexpected shapes (n_in %d, in0 %d, out %d, ws %zu); nothing launched\n", n_in, n_in > 0 ? in_sizes[0] : -1, out_size, ws_size); grid = -1; return; }
        int dev = 0, cus = 0, per_cu = 0;
        if (hipGetDevice(&dev) != hipSuccess || hipDeviceGetAttribute(&cus, hipDeviceAttributeMultiprocessorCount, dev) != hipSuccess) { fprintf(stderr, "kernel_launch: device query failed\n"); grid = -1; return; }
        if (hipFuncSetAttribute((const void*)hymba_fwd, hipFuncAttributeMaxDynamicSharedMemorySize, LDS_BYTES) != hipSuccess) { fprintf(stderr, "kernel_launch: hipFuncSetAttribute failed\n"); grid = -1; return; }
        if (hipOccupancyMaxActiveBlocksPerMultiprocessor(&per_cu, (const void*)hymba_fwd, NWAVES * 64, LDS_BYTES) != hipSuccess || per_cu < 1)
            fprintf(stderr, "kernel_launch: note: occupancy query reports %d workgroups per CU\n", per_cu);
        (void)hipGetLastError();
        grid = cus;
        if (grid > 256) grid = 256;
    }
    if (grid < 0) return;
    (void)hipMemsetAsync((char*)d_ws + WS_CTL, 0, CTL_ZERO_BYTES, stream);
    Args a{};
    for (int i = 0; i < 14; ++i) a.in[i] = (const float*)d_in[i];
    a.out = (float*)d_out; a.ws = (unsigned char*)d_ws;
    a.ulo = 0; a.uhi = 192; a.qw = 0; a.sub = 3;
    if (N_LAUNCHES == 1) {
        if (PROBE_PREFIX > 0) { a.ph_lo = 0; a.ph_hi = PROBE_PREFIX; a.li = 1; a.qw = 1; hipLaunchKernelGGL(hymba_fwd, dim3(grid), dim3(NWAVES * 64), LDS_BYTES, stream, a); a.li = 0; a.qw = 0; }
        a.ph_lo = 0; a.ph_hi = N_PHASES; hipLaunchKernelGGL(hymba_fwd, dim3(grid), dim3(NWAVES * 64), LDS_BYTES, stream, a);
        if (PROBE_P1 >= 0) { a.ph_lo = 1; a.ph_hi = 2; a.li = 1; a.qw = 1; a.pmode = PROBE_P1; a.sub = 3; hipLaunchKernelGGL(hymba_fwd, dim3(grid), dim3(NWAVES * 64), LDS_BYTES, stream, a); a.pmode = 0; }
        if (PROBE_FUSED >= 0) { a.ph_lo = 2; a.ph_hi = 4; a.li = 1; a.qw = 1; a.pmode = PROBE_FUSED; hipLaunchKernelGGL(hymba_fwd, dim3(grid), dim3(NWAVES * 64), LDS_BYTES, stream, a); }
    }
    else {
        const int ph[6] = {0, 1, 2, 2, 2, 3}, sub[6] = {3, 3, 1, 1, 2, 3}, ulo[6] = {0, 0, 64, 0, 0, 0}, uhi[6] = {0, 0, 192, 64, 0, 0};
        for (int li = 0; li < 6; ++li) for (int rep = 0; rep < (li == PROBE_REP ? 2 : 1); ++rep) {
            a.ph_lo = ph[li]; a.ph_hi = ph[li] + 1; a.sub = sub[li]; a.ulo = ulo[li]; a.uhi = uhi[li]; a.qw = li * 2 + rep;
            hipLaunchKernelGGL(hymba_fwd, dim3(grid), dim3(NWAVES * 64), LDS_BYTES, stream, a);
            if (li == 1 && PROBE_MODE == 10) { a.sub = 3 | 4; hipLaunchKernelGGL(hymba_fwd, dim3(grid), dim3(NWAVES * 64), LDS_BYTES, stream, a); }
            if (li == 2 && PROBE_MODE >= 0 && PROBE_MODE < 10) { a.qw = 13; a.pmode = PROBE_MODE; hipLaunchKernelGGL(hymba_fwd, dim3(grid), dim3(NWAVES * 64), LDS_BYTES, stream, a); a.pmode = 0; } }
    }
}
```

```cpp
#include <hip/hip_runtime.h>
#include <hip/hip_bf16.h>
#include <cstdio>
#include <cstdint>
#include <cmath>

namespace pg8 {
#define PG8_LAS __attribute__((address_space(3)))
typedef unsigned short bf16_t;
typedef short bf16x8 __attribute__((ext_vector_type(8)));
typedef float f32x4 __attribute__((ext_vector_type(4)));
typedef unsigned u32x4 __attribute__((ext_vector_type(4)));
constexpr int BM = 256, BK = 64, HALF = 128, HTB = HALF * BK * 2  , STAGE_BYTES = 8 * HTB, NXCD = 8, WGM = 8;

__host__ __device__ __forceinline__ int lds_byte(int r, int c) { const int st = (r >> 4) * 2 + (c >> 5), rr = r & 15, cc = c & 31, ob = rr * 64 + cc * 2; return st * 1024 + (ob ^ (((ob >> 9) & 1) << 5)); }
__host__ __device__ __forceinline__ void stage_rc(int b, int& R, int& C) { const int st = b / 1024, sb = b % 1024, swz = sb ^ (((sb >> 9) & 1) << 5); R = (st >> 1) * 16 + swz / 64; C = (st & 1) * 32 + (swz % 64) / 2; }
__host__ __device__ __forceinline__ int perm32(int rho) { const int n = rho >> 4, i = rho & 15; return 8 * (i >> 2) + 4 * n + (i & 3); }

struct Unit { int pm, pn; };
struct Gemm { const bf16_t* A; const bf16_t* Bt; int M, N, K; };

struct StaticOrder {
    int nM, nN, nwg, G, c;
    __host__ __device__ void init(int M, int N, int G_, int c_) { nM = M / BM; nN = N / BM; nwg = nM * nN; G = G_; c = c_; }
    __host__ __device__ bool next(int i, Unit& u) const {
        const long L = (long)i * G + c; if (L >= nwg) return false;
        int wgid = (int)L; { const int q = nwg / NXCD, r = nwg % NXCD, xcd = wgid % NXCD, off = wgid / NXCD; wgid = (xcd < r ? xcd * (q + 1) : r * (q + 1) + (xcd - r) * q) + off; }
        const int nig = WGM * nN, gid = wgid / nig, fm = gid * WGM, gsz = (nM - fm) < WGM ? (nM - fm) : WGM;
        u.pm = fm + ((wgid % nig) % gsz); u.pn = (wgid % nig) / gsz; return true;
    }
    __device__ __forceinline__ void a_ready(const Unit&) const {}
    __device__ __forceinline__ void done(const Unit&) const {}
};


typedef float pg8_f32x2 __attribute__((ext_vector_type(2))); typedef __bf16 pg8_bf16x2 __attribute__((ext_vector_type(2)));
__device__ __forceinline__ unsigned cvt_pk_bf16(float lo, float hi) { pg8_f32x2 v = {lo, hi}; pg8_bf16x2 b = __builtin_convertvector(v, pg8_bf16x2); return __builtin_bit_cast(unsigned, b); }

struct OneUnit { int pm, pn;
    __host__ __device__ bool next(int i, Unit& u) const { if (i) return false; u.pm = pm; u.pn = pn; return true; }
    __device__ __forceinline__ void a_ready(const Unit&) const {}
    __device__ __forceinline__ void done(const Unit&) const {}
};
struct EpiProj {
    static constexpr bool PERM = true, AFTER_DRAIN = false;
    bf16_t* O; int ldc; const float* gq; const float* gk; const float* gmq; float qscale; int skip;
    unsigned stg_off;
    template <int MODE> __device__ __forceinline__ void body(const f32x4 (&acc)[2][2][4][2], const Unit& u, int wr, int wc, int fr, int fq, const float* gain, float gs) const {
        int lane = fq * 16 + fr; asm volatile("" : "+v"(lane));
        const int fr_ = lane & 15, fq_ = lane >> 4;
        PG8_LAS unsigned char* sw = (PG8_LAS unsigned char*)(size_t)(stg_off + (unsigned)(wr * 4 + wc) * 2304u);
        PG8_LAS unsigned char* swr = sw + fr_ * 144 + fq_ * 16;
        const PG8_LAS unsigned char* srd = sw + (lane >> 3) * 144 + (lane & 7) * 16;
        bf16_t* gout = O + (size_t)(u.pm * BM + wr * 64 + (lane >> 3)) * ldc + u.pn * BM + wc * 64 + (lane & 7) * 8;
        f32x4 gv[2][2];
        if (MODE == 2) {
#pragma unroll
            for (int bj = 0; bj < 2; ++bj)
#pragma unroll
                for (int n = 0; n < 2; ++n) gv[bj][n] = *(const f32x4*)(gain + bj * 32 + 8 * fq_ + 4 * n) * gs; }
        auto mk = [&](int ai, int m, u32x4 (&w)[2]) {
            float r = 1.f;
            if (MODE == 2) {
                float ss = 0.f;
#pragma unroll
                for (int bj = 0; bj < 2; ++bj)
#pragma unroll
                    for (int n = 0; n < 2; ++n) { const f32x4 x = acc[ai][bj][m][n]; ss = fmaf(x[0], x[0], ss); ss = fmaf(x[1], x[1], ss); ss = fmaf(x[2], x[2], ss); ss = fmaf(x[3], x[3], ss); }
                ss += __shfl_xor(ss, 16); ss += __shfl_xor(ss, 32);
                r = __builtin_amdgcn_rsqf(ss * (1.0f / 64.0f) + 1e-6f);
            }
#pragma unroll
            for (int bj = 0; bj < 2; ++bj) {
                f32x4 v0 = acc[ai][bj][m][0], v1 = acc[ai][bj][m][1];
                if (MODE == 1) {
#pragma unroll
                    for (int i = 0; i < 4; ++i) { v0[i] = v0[i] * __builtin_amdgcn_rcpf(1.0f + __builtin_amdgcn_exp2f(-1.4426950408889634f * v0[i]));
                                                  v1[i] = v1[i] * __builtin_amdgcn_rcpf(1.0f + __builtin_amdgcn_exp2f(-1.4426950408889634f * v1[i])); }
                } else if (MODE == 2) { v0 = v0 * r * gv[bj][0]; v1 = v1 * r * gv[bj][1]; }
                w[bj].x = cvt_pk_bf16(v0[0], v0[1]); w[bj].y = cvt_pk_bf16(v0[2], v0[3]); w[bj].z = cvt_pk_bf16(v1[0], v1[1]); w[bj].w = cvt_pk_bf16(v1[2], v1[3]);
            } };
        u32x4 wn[2]; mk(0, 0, wn);
#pragma unroll
        for (int c = 0; c < 8; ++c) {
            *(PG8_LAS u32x4*)(swr) = wn[0]; *(PG8_LAS u32x4*)(swr + 64) = wn[1];
            const u32x4 o0 = *(const PG8_LAS u32x4*)(srd), o1 = *(const PG8_LAS u32x4*)(srd + 8 * 144);
            if (c < 7) mk((c + 1) >> 2, (c + 1) & 3, wn);
            bf16_t* gp = gout + (size_t)((c >> 2) * HALF + (c & 3) * 16) * ldc;
            __builtin_nontemporal_store(o0, (u32x4*)(gp)); __builtin_nontemporal_store(o1, (u32x4*)(gp + (size_t)8 * ldc));
        }
    }
    __device__ __forceinline__ void operator()(const f32x4 (&acc)[2][2][4][2], const Unit& u, int wr, int wc, int fr, int fq) const {
        if (skip) return;
        const int pn = u.pn;
        if (pn == 1 || pn == 8 || pn == 9 || pn == 11) body<1>(acc, u, wr, wc, fr, fq, nullptr, 1.f);
        else if (pn == 2 || pn == 3) body<2>(acc, u, wr, wc, fr, fq, gq, qscale);
        else if (pn == 4 || pn == 5) body<2>(acc, u, wr, wc, fr, fq, gk, 1.f);
        else if (pn == 10) body<2>(acc, u, wr, wc, fr, fq, gmq, qscale);
        else body<0>(acc, u, wr, wc, fr, fq, nullptr, 1.f);
    }
};
struct EpiRes {
    static constexpr bool PERM = false, AFTER_DRAIN = false;
    const float* base; float* out; int ldc; int mode;
    __device__ __forceinline__ void operator()(const f32x4 (&acc)[2][2][4][2], const Unit& u, int wr, int wc, int fr, int fq) const {
        const int col0 = u.pn * BM + wc * 32 + 4 * fq;
        if (mode == 2) return;
        if (mode == 1) {
#pragma unroll
            for (int ai = 0; ai < 2; ++ai)
#pragma unroll
                for (int m = 0; m < 4; ++m) { const size_t off = (size_t)(u.pm * BM + ai * HALF + wr * 64 + m * 16 + fr) * ldc + col0;
#pragma unroll
                    for (int bj = 0; bj < 2; ++bj)
#pragma unroll
                        for (int n = 0; n < 2; ++n) *(f32x4*)(out + off + bj * HALF + n * 16) = acc[ai][bj][m][n]; }
            return; }
#pragma unroll
        for (int ai = 0; ai < 2; ++ai) {
            f32x4 bs[4][2][2];
#pragma unroll
            for (int m = 0; m < 4; ++m) { const size_t off = (size_t)(u.pm * BM + ai * HALF + wr * 64 + m * 16 + fr) * ldc + col0;
#pragma unroll
                for (int bj = 0; bj < 2; ++bj)
#pragma unroll
                    for (int n = 0; n < 2; ++n) bs[m][bj][n] = *(const f32x4*)(base + off + bj * HALF + n * 16); }
#pragma unroll
            for (int m = 0; m < 4; ++m) { const size_t off = (size_t)(u.pm * BM + ai * HALF + wr * 64 + m * 16 + fr) * ldc + col0;
#pragma unroll
                for (int bj = 0; bj < 2; ++bj)
#pragma unroll
                    for (int n = 0; n < 2; ++n) *(f32x4*)(out + off + bj * HALF + n * 16) = bs[m][bj][n] + acc[ai][bj][m][n]; }
            asm volatile("" ::: "memory");
        }
    }
};

struct EpiResLds {
    static constexpr bool PERM = false, AFTER_DRAIN = true;
    const bf16_t* xh; const float* rms; float* out; int ldc; int mode;
    __device__ __forceinline__ void operator()(const f32x4 (&)[2][2][4][2], const Unit&, int, int, int, int) const {}
    __device__ __forceinline__ void fused(f32x4 (&acc)[2][2][4][2], const Unit& u, int wr, int wc, int fr, int fq, PG8_LAS unsigned char* lds, int wid, int lane) const {
        constexpr int RP = 1040;
        typedef unsigned v2u_t __attribute__((ext_vector_type(2)));
        if (mode == 2) return;
        v2u_t xra[2][16]; float rmsa[2];
#pragma unroll
        for (int ai = 0; ai < 2; ++ai) {
            const size_t goff = (size_t)(u.pm * BM + ai * HALF + 16 * wid) * ldc + (size_t)u.pn * BM + 4 * lane;
            rmsa[ai] = rms[u.pm * BM + ai * HALF + 16 * wid + (lane & 15)];
#pragma unroll
            for (int i = 0; i < 16; ++i) xra[ai][i] = (mode == 1) ? (v2u_t){0u, 0u} : __builtin_nontemporal_load((const v2u_t*)(xh + goff + (size_t)i * ldc));
        }
#pragma unroll
        for (int ai = 0; ai < 2; ++ai) {
            const size_t goff = (size_t)(u.pm * BM + ai * HALF + 16 * wid) * ldc + (size_t)u.pn * BM + 4 * lane;
            const v2u_t (&xr)[16] = xra[ai]; const float rmsl = rmsa[ai];
#pragma unroll
            for (int m = 0; m < 4; ++m)
#pragma unroll
                for (int bj = 0; bj < 2; ++bj)
#pragma unroll
                    for (int n = 0; n < 2; ++n) *(PG8_LAS f32x4*)(lds + (wr * 64 + m * 16 + fr) * RP + (bj * HALF + wc * 32 + n * 16 + 4 * fq) * 4) = acc[ai][bj][m][n];
            asm volatile("s_waitcnt lgkmcnt(0)" ::: "memory"); __builtin_amdgcn_s_barrier(); asm volatile("" ::: "memory");
#pragma unroll
            for (int i = 0; i < 16; ++i) { const f32x4 v = *(const PG8_LAS f32x4*)(lds + (16 * wid + i) * RP + 16 * lane);
                const float r = __uint_as_float(__builtin_amdgcn_readlane(__float_as_uint(rmsl), i));
                f32x4 xv; xv.x = __uint_as_float(xr[i].x << 16); xv.y = __uint_as_float(xr[i].x & 0xffff0000u); xv.z = __uint_as_float(xr[i].y << 16); xv.w = __uint_as_float(xr[i].y & 0xffff0000u);
                __builtin_nontemporal_store(v + xv * r, (f32x4*)(out + goff + (size_t)i * ldc)); }
            asm volatile("s_waitcnt lgkmcnt(0)" ::: "memory"); __builtin_amdgcn_s_barrier(); asm volatile("" ::: "memory");
        }
    }
};

template <class Epi, class Sched, bool ALIGN_EPI = false, bool SP2 = false>
__device__ __forceinline__ void gemm_phase(PG8_LAS unsigned char* lds, const Gemm g, const Sched& S, const Epi& E) {
    int tid_ = threadIdx.x; asm volatile("" : "+v"(tid_));
    const int tid = tid_, wid = __builtin_amdgcn_readfirstlane(tid >> 6), lane = tid & 63, wr = wid >> 2, wc = wid & 3, fr = lane & 15, fq = lane >> 4;
    const int K = g.K, nt = K / BK;
    unsigned voffA[2], voffB[2];
#pragma unroll
    for (int i = 0; i < 2; ++i) { int R, C; stage_rc(tid * 16 + i * 8192, R, C); const int Rb = Epi::PERM ? ((R & ~31) + perm32(R & 31)) : R;
        voffA[i] = (unsigned)(R * K + C) * 2u; voffB[i] = (unsigned)(Rb * K + C) * 2u; }
    const size_t kstep = (size_t)(BK * 2);
    const size_t hstep = (size_t)HALF * K * 2;
    const size_t tstep = 2 * hstep;
    const unsigned ldsw = (unsigned)wid * 1024u;
    const int aoff = lds_byte(wr * 64 + fr, fq * 8), boff = lds_byte(wc * 32 + fr, fq * 8);
#define PG8_SA(b, h) (((b) * 2 + (h)) * HTB)
#define PG8_SB(b, h) ((4 + (b) * 2 + (h)) * HTB)
#define PG8_STAGE(bufoff, gbase, voff) do { _Pragma("unroll") for (int _i = 0; _i < 2; ++_i) \
        __builtin_amdgcn_global_load_lds((const unsigned*)((const char*)(gbase) + (voff)[_i]), (PG8_LAS unsigned*)(lds + (bufoff) + ldsw + _i * 8192), 16, 0, 0); } while (0)
#define PG8_LDA(dst, b, h) do { _Pragma("unroll") for (int m = 0; m < 4; ++m) _Pragma("unroll") for (int k = 0; k < 2; ++k) dst[m][k] = *(const PG8_LAS bf16x8*)(lds + PG8_SA(b, h) + aoff + m * 2048 + k * 1024); } while (0)
#define PG8_LDB(dst, b, h) do { _Pragma("unroll") for (int n = 0; n < 2; ++n) _Pragma("unroll") for (int k = 0; k < 2; ++k) dst[n][k] = *(const PG8_LAS bf16x8*)(lds + PG8_SB(b, h) + boff + n * 2048 + k * 1024); } while (0)
#define PG8_MMA(ai, bj, At, Bt) do { __builtin_amdgcn_s_setprio(1); _Pragma("unroll") for (int m = 0; m < 4; ++m) _Pragma("unroll") for (int n = 0; n < 2; ++n) _Pragma("unroll") for (int k = 0; k < 2; ++k) \
        acc[ai][bj][m][n] = __builtin_amdgcn_mfma_f32_16x16x32_bf16(Bt[n][k], At[m][k], acc[ai][bj][m][n], 0, 0, 0); __builtin_amdgcn_s_setprio(0); } while (0)
#define PG8_WAIT_V(n) asm volatile("s_waitcnt vmcnt(" #n ")" ::: "memory")
#define PG8_WAIT_L(n) asm volatile("s_waitcnt lgkmcnt(" #n ")" ::: "memory")
#define PG8_BAR __builtin_amdgcn_s_barrier()
#define PG8_SCHED __builtin_amdgcn_sched_barrier(0)
    Unit cur, nxt; int ui = 0;
    if (!S.next(0, cur)) return;
    f32x4 acc[2][2][4][2];
#pragma unroll
    for (int a = 0; a < 2; ++a)
#pragma unroll
        for (int b = 0; b < 2; ++b)
#pragma unroll
            for (int m = 0; m < 4; ++m)
#pragma unroll
                for (int n = 0; n < 2; ++n) acc[a][b][m][n] = (f32x4){0.f, 0.f, 0.f, 0.f};
    bf16x8 At[4][2], B0[2][2], B1[2][2];
    const char* cA = (const char*)g.A + (size_t)cur.pm * tstep; const char* cB = (const char*)g.Bt + (size_t)cur.pn * tstep;
    S.a_ready(cur);
    if constexpr (SP2) {
        PG8_STAGE(PG8_SB(0, 0), cB, voffB); PG8_STAGE(PG8_SB(0, 1), cB + hstep, voffB); PG8_STAGE(PG8_SA(0, 0), cA, voffA); PG8_STAGE(PG8_SA(0, 1), cA + hstep, voffA);
        if (wr == 1) PG8_BAR;
        PG8_WAIT_V(2); PG8_BAR;
        PG8_STAGE(PG8_SB(1, 0), cB + kstep, voffB); PG8_STAGE(PG8_SA(1, 0), cA + kstep, voffA); PG8_STAGE(PG8_SB(1, 1), cB + hstep + kstep, voffB);
        PG8_WAIT_V(6); PG8_BAR;
    } else {
        PG8_STAGE(PG8_SB(0, 0), cB, voffB); PG8_STAGE(PG8_SA(0, 0), cA, voffA); PG8_STAGE(PG8_SB(0, 1), cB + hstep, voffB); PG8_STAGE(PG8_SA(0, 1), cA + hstep, voffA);
        if (wr == 1) PG8_BAR;
        PG8_WAIT_V(4); PG8_BAR;
        PG8_STAGE(PG8_SB(1, 0), cB + kstep, voffB); PG8_STAGE(PG8_SA(1, 0), cA + kstep, voffA); PG8_STAGE(PG8_SB(1, 1), cB + hstep + kstep, voffB);
        PG8_WAIT_V(6); PG8_BAR;
    }
    for (;;) {
        const bool has_next = S.next(ui + 1, nxt);
        const char* nA = has_next ? (const char*)g.A + (size_t)nxt.pm * tstep : cA; const char* nB = has_next ? (const char*)g.Bt + (size_t)nxt.pn * tstep : cB;
        for (int t = 0; t < nt; t += 2) {
            const bool last = (t == nt - 2);
            const char* a1 = cA + (size_t)(t + 1) * kstep;
            const char* a2 = last ? nA : cA + (size_t)(t + 2) * kstep; const char* b2 = last ? nB : cB + (size_t)(t + 2) * kstep;
            const char* a3 = a2 + kstep; const char* b3 = b2 + kstep;
            if (last && has_next) S.a_ready(nxt);
            if constexpr (SP2) {
            PG8_LDB(B0, 0, 0); PG8_LDB(B1, 0, 1); PG8_SCHED; PG8_LDA(At, 0, 0); PG8_STAGE(PG8_SA(1, 1), a1 + hstep, voffA);
            PG8_WAIT_V(8); PG8_WAIT_L(0); PG8_BAR; PG8_MMA(0, 0, At, B0); PG8_MMA(0, 1, At, B1); PG8_BAR; PG8_SCHED;
            PG8_LDA(At, 0, 1); PG8_STAGE(PG8_SB(0, 0), b2, voffB); PG8_STAGE(PG8_SB(0, 1), b2 + hstep, voffB); PG8_STAGE(PG8_SA(0, 0), a2, voffA);
            PG8_WAIT_V(8); PG8_WAIT_L(0); PG8_BAR; PG8_MMA(1, 0, At, B0); PG8_MMA(1, 1, At, B1); PG8_BAR; PG8_SCHED;
            PG8_LDB(B0, 1, 0); PG8_LDB(B1, 1, 1); PG8_SCHED; PG8_LDA(At, 1, 0); PG8_STAGE(PG8_SA(0, 1), a2 + hstep, voffA);
            PG8_WAIT_V(8); PG8_WAIT_L(0); PG8_BAR; PG8_MMA(0, 0, At, B0); PG8_MMA(0, 1, At, B1); PG8_BAR; PG8_SCHED;
            PG8_LDA(At, 1, 1); PG8_STAGE(PG8_SB(1, 0), b3, voffB); PG8_STAGE(PG8_SB(1, 1), b3 + hstep, voffB); PG8_STAGE(PG8_SA(1, 0), a3, voffA);
            PG8_WAIT_V(8); PG8_WAIT_L(0); PG8_BAR; PG8_MMA(1, 0, At, B0); PG8_MMA(1, 1, At, B1); PG8_BAR; PG8_SCHED;
            } else {
            PG8_LDB(B0, 0, 0); PG8_SCHED; PG8_LDA(At, 0, 0); PG8_STAGE(PG8_SA(1, 1), a1 + hstep, voffA);
            PG8_WAIT_L(8); PG8_BAR; PG8_WAIT_L(0); PG8_MMA(0, 0, At, B0); PG8_BAR; PG8_SCHED;
            PG8_LDB(B1, 0, 1); PG8_STAGE(PG8_SB(0, 0), b2, voffB);
            PG8_BAR; PG8_WAIT_L(0); PG8_MMA(0, 1, At, B1); PG8_BAR;
            PG8_LDA(At, 0, 1); PG8_STAGE(PG8_SA(0, 0), a2, voffA);
            PG8_BAR; PG8_WAIT_L(0); PG8_MMA(1, 0, At, B0); PG8_BAR; PG8_SCHED;
            PG8_STAGE(PG8_SB(0, 1), b2 + hstep, voffB);
            PG8_WAIT_V(6); PG8_BAR; PG8_MMA(1, 1, At, B1); PG8_BAR;
            PG8_LDB(B0, 1, 0); PG8_SCHED; PG8_LDA(At, 1, 0); PG8_STAGE(PG8_SA(0, 1), a2 + hstep, voffA);
            PG8_WAIT_L(8); PG8_BAR; PG8_WAIT_L(0); PG8_MMA(0, 0, At, B0); PG8_BAR; PG8_SCHED;
            PG8_LDB(B1, 1, 1); PG8_STAGE(PG8_SB(1, 0), b3, voffB);
            PG8_BAR; PG8_WAIT_L(0); PG8_MMA(0, 1, At, B1); PG8_BAR;
            PG8_LDA(At, 1, 1); PG8_STAGE(PG8_SA(1, 0), a3, voffA);
            PG8_BAR; PG8_WAIT_L(0); PG8_MMA(1, 0, At, B0); PG8_BAR; PG8_SCHED;
            PG8_STAGE(PG8_SB(1, 1), b3 + hstep, voffB);
            PG8_WAIT_V(6); PG8_BAR; PG8_MMA(1, 1, At, B1); PG8_BAR;
            }
        }
        if constexpr (ALIGN_EPI) { if (wr == 0) PG8_BAR; }
        if constexpr (!Epi::AFTER_DRAIN) { E(acc, cur, wr, wc, fr, fq); S.done(cur); }
        if (!has_next) break;
#pragma unroll
        for (int a = 0; a < 2; ++a)
#pragma unroll
            for (int b = 0; b < 2; ++b)
#pragma unroll
                for (int m = 0; m < 4; ++m)
#pragma unroll
                    for (int n = 0; n < 2; ++n) acc[a][b][m][n] = (f32x4){0.f, 0.f, 0.f, 0.f};
        cur = nxt; cA = nA; cB = nB; ++ui;
        if constexpr (ALIGN_EPI) { if (wr == 1) PG8_BAR; }
    }
    PG8_WAIT_V(0);
    if constexpr (!ALIGN_EPI) { if (wr == 0) PG8_BAR; }
    PG8_BAR;
    if constexpr (Epi::AFTER_DRAIN) { E.fused(acc, cur, wr, wc, fr, fq, lds, wid, lane); S.done(cur); }
#undef PG8_SA
#undef PG8_SB
#undef PG8_STAGE
#undef PG8_LDA
#undef PG8_LDB
#undef PG8_MMA
#undef PG8_WAIT_V
#undef PG8_WAIT_L
#undef PG8_BAR
#undef PG8_SCHED
}
}


namespace attn {
using bf16 = unsigned short;
using bf16x8 = __attribute__((ext_vector_type(8))) short;
using s16x4 = __attribute__((ext_vector_type(4))) short;
using f32x16 = __attribute__((ext_vector_type(16))) float;
using f32x4 = __attribute__((ext_vector_type(4))) float;
using u32x4 = __attribute__((ext_vector_type(4))) unsigned;
constexpr int NW = 8, QBLK = 32, QB = QBLK * NW, KVBLK = 64;
constexpr int NSLOT = 3, SLOTB = 8192;
constexpr int LDS_K = 0, LDS_V = NSLOT * SLOTB, LDS_WS = 2 * NSLOT * SLOTB, LDS_OST = LDS_WS + NW * 64 * 4, LDS_G = LDS_OST + NW * 4096, LDS_GZ = 141312  , LDS_Q = LDS_G + 16384  , LDS_BYTES = LDS_Q + QB * 128;
#define ALAS __attribute__((address_space(3)))
#define SBAR() __builtin_amdgcn_sched_barrier(0)
__device__ __forceinline__ int crow(int r, int hi) { return (r & 3) + 8 * (r >> 2) + 4 * hi; }
__device__ __forceinline__ void cmask(f32x16& p0, f32x16& p1, int jb, int qrel, int hi) {
    const float NEG = -INFINITY; int dq = qrel - 64 * jb - 4 * hi;
    asm volatile("" : "+v"(dq));
#pragma unroll
    for (int r = 0; r < 16; ++r) { const int c = (r & 3) + 8 * (r >> 2); if (c > dq) p0[r] = NEG; if (c + 32 > dq) p1[r] = NEG; }
}
__device__ __forceinline__ void glds16(const void* gsrc, unsigned lds_dst) { unsigned keep;
    asm volatile("s_mov_b32 %0, m0\n\ts_mov_b32 m0, %2\n\ts_nop 0\n\tglobal_load_lds_dwordx4 %1, off\n\ts_mov_b32 m0, %0" : "=&s"(keep) : "v"(gsrc), "s"(lds_dst) : "memory"); }
__device__ __forceinline__ void glds16s(const void* sbase, unsigned voff, unsigned lds_dst) { unsigned keep;
    asm volatile("s_nop 4\n\ts_mov_b32 %0, m0\n\ts_mov_b32 m0, %3\n\ts_nop 0\n\tglobal_load_lds_dwordx4 %1, %2\n\ts_mov_b32 m0, %0" : "=&s"(keep) : "v"(voff), "s"(sbase), "s"(lds_dst) : "memory"); }
__device__ __forceinline__ void glds16s_nt(const void* sbase, unsigned voff, unsigned lds_dst) { unsigned keep;
    asm volatile("s_nop 4\n\ts_mov_b32 %0, m0\n\ts_mov_b32 m0, %3\n\ts_nop 0\n\tglobal_load_lds_dwordx4 %1, %2 nt\n\ts_mov_b32 m0, %0" : "=&s"(keep) : "v"(voff), "s"(sbase), "s"(lds_dst) : "memory"); }
__device__ __forceinline__ void st16_wt(void* p, u32x4 v) { asm volatile("global_store_dwordx4 %0, %1, off sc1\n\ts_nop 1" :: "v"(p), "v"(v) : "memory"); }
typedef float f32x2_t __attribute__((ext_vector_type(2))); typedef __bf16 bf16x2_t __attribute__((ext_vector_type(2)));
__device__ __forceinline__ unsigned cvtpk_s(float lo, float hi) { f32x2_t v = {lo, hi}; bf16x2_t b = __builtin_convertvector(v, bf16x2_t); return __builtin_bit_cast(unsigned, b); }
#define WAIT_BAR(N) asm volatile("s_waitcnt vmcnt(" #N ") lgkmcnt(0)\n\ts_barrier" ::: "memory")
typedef ALAS const char* lds_cptr;
typedef short v4i16_t __attribute__((ext_vector_type(4)));
__device__ __forceinline__ void kload2(bf16x8* kf, lds_cptr kp, int kq, int j) { kf[2 * j] = *(const ALAS bf16x8*)(kp + ((32 * j) ^ kq)); kf[2 * j + 1] = *(const ALAS bf16x8*)(kp + ((32 * j) ^ kq) + 4096); }
__device__ __forceinline__ void kload8(bf16x8* kf, lds_cptr kp, int kq) { kload2(kf, kp, kq, 0); kload2(kf, kp, kq, 1); kload2(kf, kp, kq, 2); kload2(kf, kp, kq, 3); }
__device__ __forceinline__ s16x4 vtr(lds_cptr p) { return __builtin_bit_cast(s16x4, __builtin_amdgcn_ds_read_tr16_b64_v4i16((ALAS v4i16_t*)p)); }
__device__ __forceinline__ void bias_split(float gp, unsigned& x0, unsigned& x1) {
    const unsigned b1 = __float_as_uint(gp) & 0xffff0000u; const float r1 = gp - __uint_as_float(b1);
    const unsigned b2 = __float_as_uint(r1) & 0xffff0000u; const float r2 = r1 - __uint_as_float(b2);
    const unsigned b3 = __float_as_uint(r2) & 0xffff0000u;
    x0 = (b1 >> 16) | b2; x1 = (b3 >> 16) | 0x3f800000u;
}
__device__ __forceinline__ unsigned mul_bf16x2(unsigned a, unsigned b) {
    const float al = __uint_as_float(a << 16), ah = __uint_as_float(a & 0xffff0000u), bl = __uint_as_float(b << 16), bh = __uint_as_float(b & 0xffff0000u);
    return cvtpk_s(al * bl, ah * bh);
}

struct Desc {
    const bf16* Q; const bf16* K; const bf16* V; const bf16* gate; bf16* O; const float* G;
    int qpitch, kvpitch, gpitch, opitch;
    int NT, t0, causal, q0;
    float negB;
    int dmaprobe;
    int wt;
    int qpre;
    unsigned* qctr; unsigned hookQ;
    unsigned pendA, pendL; unsigned hookA, hookL;
};

template <class NQ>
__device__ __forceinline__ void unit(const Desc& d, char* shm, const NQ& nextq) {
    int tid_ = threadIdx.x; asm volatile("" : "+v"(tid_));
    const int tid = tid_, lane = tid & 63, r32 = lane & 31, hi = lane >> 5; const int wid = __builtin_amdgcn_readfirstlane(tid >> 6);
    const int kvp = d.kvpitch, t0 = d.t0, NT = d.NT - t0;
    const bool hasg = d.G != nullptr, causal = d.causal != 0;
    const unsigned lds0 = (unsigned)(uintptr_t)shm;
    const lds_cptr shm3 = (lds_cptr)shm;
    ALAS float* wsf = (ALAS float*)(shm3 + LDS_WS) + wid * 64;
    const long tstep = (long)KVBLK * kvp;
    const bf16* kbase = d.K + (long)(t0 * KVBLK + 8 * wid) * kvp;
    const bf16* vbase = d.V + (long)(t0 * KVBLK + 8 * wid) * kvp;
    const unsigned koff = (unsigned)((lane >> 3) * kvp + (((lane & 7) ^ ((4 * wid + (lane >> 4)) & 7)) * 8)) * 2u;
    const unsigned voff = (unsigned)((lane >> 3) * kvp + (((lane & 7) ^ (((lane >> 4) & 1) * 4)) * 8)) * 2u;
    const unsigned kdst = lds0 + LDS_K + wid * 1024, vdst = lds0 + LDS_V + wid * 1024;
#define DMA_K(t, slot) glds16s(kbase + (long)(t) * tstep, koff, (unsigned)__builtin_amdgcn_readfirstlane(kdst + (slot)))
#define DMA_V(t, slot) glds16s(vbase + (long)(t) * tstep, voff, (unsigned)__builtin_amdgcn_readfirstlane(vdst + (slot)))
    const lds_cptr kp0 = shm3 + LDS_K + r32 * 128;
    const int kq0 = (((r32 >> 1) & 6) << 4) | ((hi ^ ((r32 >> 1) & 1)) << 4);
    const int vq_ = (lane & 15) >> 2, vsw_ = (vq_ >> 1) & 1;
    const lds_cptr vp0 = shm3 + LDS_V + (4 * hi + vq_) * 128 + ((lane >> 4) & 1) * 32 + (lane & 3) * 8 + vsw_ * 64;
    const lds_cptr vp1 = shm3 + LDS_V + (4 * hi + vq_) * 128 + ((lane >> 4) & 1) * 32 + (lane & 3) * 8 + (1 - vsw_) * 64;
    const unsigned qvA = (unsigned)((lane >> 3) * d.qpitch + (((lane & 7) ^ (lane >> 4)) * 8)) * 2u, qvB = qvA ^ 64u;
    const unsigned qdst = lds0 + LDS_Q + wid * 4096;
#define DMA_Q(Qb) do { _Pragma("unroll") for (int j_ = 0; j_ < 4; ++j_) glds16s_nt((Qb) + (long)(wid * QBLK + 8 * j_) * d.qpitch, (j_ & 1) ? qvB : qvA, (unsigned)__builtin_amdgcn_readfirstlane(qdst + j_ * 1024)); } while (0)
    if (!d.qpre) DMA_Q(d.Q);
    if (hasg) { const int plo = (t0 * KVBLK) >> 8, phi = (d.NT * KVBLK - 1) >> 8;
        for (int p = plo + wid; p <= phi; p += NW) glds16s(d.G + p * 256, (unsigned)lane * 16u, (unsigned)__builtin_amdgcn_readfirstlane(lds0 + LDS_G + p * 1024)); }
    const lds_cptr gl0 = hasg ? shm3 + LDS_G + t0 * 256 + lane * 4 : shm3 + LDS_GZ + lane * 4; const int gstep = hasg ? 256 : 0;
    DMA_K(0, 0); DMA_V(0, 0); DMA_K(1, SLOTB);
    bf16x8 qr[4]; float Gref; bf16x8 bq;
#define Q_AND_BIAS() do { \
    _Pragma("unroll") for (int d0 = 0; d0 < 4; ++d0) qr[d0] = *(const ALAS bf16x8*)(shm3 + LDS_Q + wid * 4096 + r32 * 128 + ((32 * d0) ^ kq0));     \
    Gref = hasg ? *(const ALAS float*)(shm3 + LDS_G + d.q0 * 4) : 0.f;                                \
      \
    { const float aq = hasg ? (*(const ALAS float*)(shm3 + LDS_G + (d.q0 + wid * QBLK + r32) * 4) - Gref) + d.negB : d.negB; \
      const unsigned a1 = __float_as_uint(aq) & 0xffff0000u; const float r1 = aq - __uint_as_float(a1); \
      const unsigned a2 = __float_as_uint(r1) & 0xffff0000u; const float r2 = r1 - __uint_as_float(a2); \
      const unsigned a3 = __float_as_uint(r2) & 0xffff0000u; \
      bq = __builtin_bit_cast(bf16x8, (u32x4){0x3f803f80u, 0x3f80u | a1, (a2 >> 16) | a3, 0u}); } } while (0)
    unsigned bx0, bx1;
#define BFRAG0 __builtin_bit_cast(bf16x8, (u32x4){hi ? 0u : bx0, hi ? 0u : bx1, hi ? 0u : 0x3f803f80u, 0u})
#define BFRAG1 __builtin_bit_cast(bf16x8, (u32x4){hi ? bx0 : 0u, hi ? bx1 : 0u, hi ? 0x3f803f80u : 0u, 0u})
#define ZERO16 (f32x16){}
    float l_reg = 0.f; f32x16 o[2]; o[0] = f32x16{}; o[1] = f32x16{};
    const int qrel = wid * QBLK + r32;
    f32x16 pA0, pA1, pB0, pB1; bf16x8 kf[8];
    int sl_prev = 0, sl_cur = 0, sl_next = SLOTB;
#define ROT() do { sl_prev = sl_cur; sl_cur = sl_next; sl_next = (sl_next == (NSLOT - 1) * SLOTB) ? 0 : sl_next + SLOTB; } while (0)
    DMA_K(2, 2 * SLOTB);
    WAIT_BAR(3);
    Q_AND_BIAS();
#define MFMA(a, b, c) __builtin_amdgcn_mfma_f32_32x32x16_bf16(a, b, c, 0, 0, 0)
    bias_split(Gref - *(const ALAS float*)(gl0), bx0, bx1);
    kload8(kf, kp0, kq0);
    pA0 = MFMA(BFRAG0, bq, ZERO16); pA1 = MFMA(BFRAG1, bq, ZERO16);
    pA0 = MFMA(kf[0], qr[0], pA0); pA1 = MFMA(kf[1], qr[0], pA1); pA0 = MFMA(kf[2], qr[1], pA0); pA1 = MFMA(kf[3], qr[1], pA1);
    pA0 = MFMA(kf[4], qr[2], pA0); pA1 = MFMA(kf[5], qr[2], pA1); pA0 = MFMA(kf[6], qr[3], pA0); pA1 = MFMA(kf[7], qr[3], pA1);
    if (causal && NT == 4) cmask(pA0, pA1, 0, qrel, hi);
#pragma unroll
    for (int r = 0; r < 16; ++r) { pA0[r] = __builtin_amdgcn_exp2f(pA0[r]); pA1[r] = __builtin_amdgcn_exp2f(pA1[r]); }
    bias_split(Gref - *(const ALAS float*)(gl0 + gstep), bx0, bx1);
    WAIT_BAR(0);
    if (tid == 0) { *(volatile ALAS unsigned*)(shm3 + d.hookA) = d.pendA; *(volatile ALAS unsigned*)(shm3 + d.hookL) = d.pendL; }
    DMA_K(3, 0); DMA_V(1, SLOTB);
    ROT();
    kload8(kf, kp0 + sl_cur, kq0);
    WAIT_BAR(2);
    s16x4 vlo[4], vhi[4]; u32x4 pw0, pw1, pw2, pw3;
#define PKW(P, B) cvtpk_s(P[B], P[B + 1])
#define PAF(k) __builtin_bit_cast(bf16x8, pw##k)
#define VSL(i) ((((i) & 1) << 1) | (((i) >> 2) & 1))
#define VFR(i) (bf16x8){vlo[VSL(i)][0], vlo[VSL(i)][1], vlo[VSL(i)][2], vlo[VSL(i)][3], vhi[VSL(i)][0], vhi[VSL(i)][1], vhi[VSL(i)][2], vhi[VSL(i)][3]}
#define PIN(x) asm volatile("" : "+v"(x))
#define GAPA(MF, A0, A1, A2, A3, W0, W1, PW) do { MF; sacc += A0; sacc += A1; sacc += A2; sacc += A3; PIN(sacc); W0; W1; PIN(PW); SBAR(); } while (0)
#define EX(v) __builtin_amdgcn_exp2f(v)
#define GAPB(MF, X, B) do { MF; X[B] = EX(X[B]); X[B + 1] = EX(X[B + 1]); X[B + 2] = EX(X[B + 2]); X[B + 3] = EX(X[B + 3]); PIN(X); SBAR(); } while (0)
#define VRD(i) do { const lds_cptr vq__ = (((i) >> 2) ? vp1 : vp0) + sl_vprev_; vlo[VSL(i)] = vtr(vq__ + ((i) & 3) * 2048); vhi[VSL(i)] = vtr(vq__ + ((i) & 3) * 2048 + 1024); } while (0)
#define KRD(G, j) do { if (G) { kload2(kf, kp0 + sl_next, kq0, j); SBAR(); } } while (0)
#define STEP(C0, C1, P0, P1, t, GK, GV, GL, MASKED) do { SBAR(); \
    const int sl_vprev_ = sl_prev; \
    C0 = MFMA(BFRAG0, bq, ZERO16); C1 = MFMA(BFRAG1, bq, ZERO16); \
    VRD(0); SBAR(); float sacc = (P0[0] + P0[1]); \
    GAPA(C0 = MFMA(kf[0], qr[0], C0), P0[2], P0[3], P0[4], P0[5],     pw0[0] = PKW(P0, 0), pw0[1] = PKW(P0, 2), pw0); \
    VRD(4); SBAR(); GAPA(C1 = MFMA(kf[1], qr[0], C1), P0[6], P0[7], P0[8], P0[9],     pw0[2] = PKW(P0, 4), pw0[3] = PKW(P0, 6), pw0); \
    VRD(1); SBAR(); GAPA(C0 = MFMA(kf[2], qr[1], C0), P0[10], P0[11], P0[12], P0[13], pw1[0] = PKW(P0, 8), pw1[1] = PKW(P0, 10), pw1); \
    VRD(5); SBAR(); GAPA(C1 = MFMA(kf[3], qr[1], C1), P0[14], P0[15], P1[0], P1[1],   pw1[2] = PKW(P0, 12), pw1[3] = PKW(P0, 14), pw1); \
    GAPA(C0 = MFMA(kf[4], qr[2], C0), P1[2], P1[3], P1[4], P1[5],     pw2[0] = PKW(P1, 0), pw2[1] = PKW(P1, 2), pw2); \
    GAPA(C1 = MFMA(kf[5], qr[2], C1), P1[6], P1[7], P1[8], P1[9],     pw2[2] = PKW(P1, 4), pw2[3] = PKW(P1, 6), pw2); \
    GAPA(C0 = MFMA(kf[6], qr[3], C0), P1[10], P1[11], P1[12], P1[13], pw3[0] = PKW(P1, 8), pw3[1] = PKW(P1, 10), pw3); \
    GAPA(C1 = MFMA(kf[7], qr[3], C1), P1[14], P1[15], 0.f, 0.f,       pw3[2] = PKW(P1, 12), pw3[3] = PKW(P1, 14), pw3); \
    l_reg += sacc; \
    if (GK) { DMA_K((t) + 3, sl_cur); } if (GV) { DMA_V((t) + 1, sl_next); } \
    if (MASKED) { const int jb_ = (t) - (NT - 4); if (causal && jb_ >= (wid >> 1)) cmask(C0, C1, jb_, qrel, hi);     } \
    float gnx_ = 0.f; if (GL) { gnx_ = *(const ALAS float*)(gl0 + ((t) + 1) * gstep); } \
    SBAR(); \
    GAPB(o[0] = MFMA(PAF(0), VFR(0), o[0]), C0, 0);  VRD(2); SBAR(); \
    GAPB(o[1] = MFMA(PAF(0), VFR(4), o[1]), C0, 4);  VRD(6); SBAR(); \
    KRD(GL, 0); GAPB(o[0] = MFMA(PAF(1), VFR(1), o[0]), C0, 8);  VRD(3); SBAR(); \
    KRD(GL, 1); GAPB(o[1] = MFMA(PAF(1), VFR(5), o[1]), C0, 12); VRD(7); SBAR(); \
    if (GL) { bias_split(Gref - gnx_, bx0, bx1); PIN(bx0); PIN(bx1); SBAR(); } \
    KRD(GL, 2); GAPB(o[0] = MFMA(PAF(2), VFR(2), o[0]), C1, 0); \
    KRD(GL, 3); GAPB(o[1] = MFMA(PAF(2), VFR(6), o[1]), C1, 4); \
    GAPB(o[0] = MFMA(PAF(3), VFR(3), o[0]), C1, 8); \
    GAPB(o[1] = MFMA(PAF(3), VFR(7), o[1]), C1, 12); \
    } while (0)
    int t = 1;
    for (; t + 5 < NT; t += 2) {
        STEP(pB0, pB1, pA0, pA1, t, true, true, true, false);     WAIT_BAR(2); ROT();
        STEP(pA0, pA1, pB0, pB1, t + 1, true, true, true, false); WAIT_BAR(2); ROT();
    }
#define ENDW(tt) do { if ((tt) + 3 < NT) { WAIT_BAR(2); } else if ((tt) + 2 < NT) { WAIT_BAR(1); } else { WAIT_BAR(0); } } while (0)
    unsigned pendq = 0u;
    for (; t + 1 < NT; t += 2) {
        if (t + 3 >= NT && tid == 0 && d.qctr) pendq = __hip_atomic_fetch_add(d.qctr, 1u, __ATOMIC_RELAXED, __HIP_MEMORY_SCOPE_AGENT);
        STEP(pB0, pB1, pA0, pA1, t, (t + 3 < NT), (t + 1 < NT), (t + 1 < NT), true);
        if (t + 3 < NT) { WAIT_BAR(2); } else if (wid == 0 && d.qctr) { WAIT_BAR(2); } else { WAIT_BAR(1); }
        ROT();
        STEP(pA0, pA1, pB0, pB1, t + 1, (t + 4 < NT), (t + 2 < NT), (t + 2 < NT), true);
        if (t + 3 < NT) { ENDW(t + 1); }
        else { asm volatile("s_waitcnt vmcnt(0)" ::: "memory"); if (tid == 0 && d.qctr) *(volatile ALAS unsigned*)(shm3 + d.hookQ) = pendq; asm volatile("s_waitcnt lgkmcnt(0)\n\ts_barrier" ::: "memory"); }
        ROT();
    }
    int le = lane; asm volatile("" : "+v"(le));
    const unsigned gsl = (unsigned)__builtin_amdgcn_readfirstlane((wid < 6) ? LDS_K + wid * 4096 : LDS_V + sl_next + (wid - 6) * 4096);
    { const bf16* gw = d.gate + (long)(wid * QBLK) * d.gpitch; const unsigned gv = (unsigned)((le >> 3) * d.gpitch + (le & 7) * 8) * 2u;
#pragma unroll
      for (int i = 0; i < 4; ++i) glds16s_nt(gw + (long)(8 * i) * d.gpitch, gv, (unsigned)__builtin_amdgcn_readfirstlane(lds0 + gsl + i * 1024)); }
    { unsigned rq = 0xffffffffu; if (d.qctr) rq = (unsigned)__builtin_amdgcn_readfirstlane(*(volatile ALAS unsigned*)(shm3 + d.hookQ));
      const bf16* nq = nextq(rq); DMA_Q(nq ? nq : d.Q); }
    STEP(pB0, pB1, pA0, pA1, NT - 1, false, false, false, true);
    { float sacc = pB0[0] + pB0[1];
#pragma unroll
      for (int r = 2; r < 16; ++r) sacc += pB0[r];
#pragma unroll
      for (int r = 0; r < 16; ++r) sacc += pB1[r];
      l_reg += sacc;
      pw0 = (u32x4){PKW(pB0, 0), PKW(pB0, 2), PKW(pB0, 4), PKW(pB0, 6)}; pw1 = (u32x4){PKW(pB0, 8), PKW(pB0, 10), PKW(pB0, 12), PKW(pB0, 14)};
      pw2 = (u32x4){PKW(pB1, 0), PKW(pB1, 2), PKW(pB1, 4), PKW(pB1, 6)}; pw3 = (u32x4){PKW(pB1, 8), PKW(pB1, 10), PKW(pB1, 12), PKW(pB1, 14)};
      SBAR();
      const int vb0_ = (int)(unsigned)(size_t)(vp0 + sl_cur), vb1_ = (int)(unsigned)(size_t)(vp1 + sl_cur);
#pragma unroll
      for (int d0 = 0; d0 < 2; ++d0) { s16x4 lo[4], hh[4];
#pragma unroll
        for (int ks = 0; ks < 4; ++ks) {
            asm volatile("ds_read_b64_tr_b16 %0,%1 offset:%c2" : "=&v"(lo[ks]) : "v"(d0 ? vb1_ : vb0_), "i"(ks * 2048) : "memory");
            asm volatile("ds_read_b64_tr_b16 %0,%1 offset:%c2" : "=&v"(hh[ks]) : "v"(d0 ? vb1_ : vb0_), "i"(ks * 2048 + 1024) : "memory"); }
        asm volatile("s_waitcnt lgkmcnt(0)" ::: "memory"); SBAR();
#define PK(k) (bf16x8){lo[k][0], lo[k][1], lo[k][2], lo[k][3], hh[k][0], hh[k][1], hh[k][2], hh[k][3]}
        __builtin_amdgcn_s_setprio(1); o[d0] = MFMA(PAF(0), PK(0), o[d0]); o[d0] = MFMA(PAF(1), PK(1), o[d0]); o[d0] = MFMA(PAF(2), PK(2), o[d0]); o[d0] = MFMA(PAF(3), PK(3), o[d0]); __builtin_amdgcn_s_setprio(0);
#undef PK
      } }
    { auto rr = __builtin_amdgcn_permlane32_swap(__float_as_uint(l_reg), __float_as_uint(l_reg), false, false); l_reg = __uint_as_float(rr[0]) + __uint_as_float(rr[1]); }
    if (hi == 0) wsf[32 + r32] = l_reg; asm volatile("s_waitcnt lgkmcnt(0)" ::: "memory");
    float rli[16];
#pragma unroll
    for (int r = 0; r < 16; ++r) rli[r] = __builtin_amdgcn_rcpf(wsf[32 + crow(r, hi)]);
    { __hip_bfloat16* stg = (__hip_bfloat16*)(shm + LDS_OST) + wid * 2048;
#pragma unroll
      for (int r = 0; r < 16; ++r) { const int orow = crow(r, hi);
#pragma unroll
        for (int d0 = 0; d0 < 2; ++d0) stg[orow * 64 + d0 * 32 + r32] = __float2bfloat16(o[d0][r] * rli[r]); }
      asm volatile("s_waitcnt lgkmcnt(0)" ::: "memory");
      bf16* ow = d.O + (long)(wid * QBLK) * d.opitch;
      asm volatile("s_waitcnt vmcnt(4)" ::: "memory");
#pragma unroll
      for (int i = 0; i < 4; ++i) { const int row = i * 8 + (le >> 3), ch = le & 7; const u32x4 v = *(const u32x4*)(stg + row * 64 + ch * 8);
        const u32x4 g = *(const ALAS u32x4*)(shm3 + gsl + i * 1024 + le * 16);
        u32x4 w; w.x = mul_bf16x2(v.x, g.x); w.y = mul_bf16x2(v.y, g.y); w.z = mul_bf16x2(v.z, g.z); w.w = mul_bf16x2(v.w, g.w);
        if (d.wt) st16_wt(ow + (long)row * d.opitch + ch * 8, w); else *(u32x4*)(ow + (long)row * d.opitch + ch * 8) = w; } }
    asm volatile("s_waitcnt lgkmcnt(0)\n\ts_barrier" ::: "memory");
#undef DMA_K
#undef DMA_Q
#undef Q_AND_BIAS
#undef DMA_V
#undef ROT
#undef MFMA
#undef PKW
#undef PAF
#undef VFR
#undef PIN
#undef GAPA
#undef GAPB
#undef EX
#undef VRD
#undef KRD
#undef STEP
#undef BFRAG0
#undef BFRAG1
#undef ZERO16
#undef ENDW
}
#undef SBAR
#undef WAIT_BAR

struct MemDesc { const bf16* Q; const bf16* gate; bf16* O; const bf16* K; const bf16* V;     int qpitch, gpitch, opitch, kvpitch; float negB; int qpre; unsigned* qctr; unsigned hookQ; };
constexpr int M2_K = 0, M2_V = 32768, M2_OST = 65536, M2_WS = 98304;
static_assert(M2_WS + NW * 64 * 4 <= LDS_Q, "memory-unit scratch below the Q tile");
__device__ __forceinline__ void mem_unit2(const MemDesc& d, char* shm) {
    int tid_ = threadIdx.x; asm volatile("" : "+v"(tid_));
    const int tid = tid_, lane = tid & 63, r32 = lane & 31, hi = lane >> 5; const int wid = __builtin_amdgcn_readfirstlane(tid >> 6);
    const int kvp = d.kvpitch;
    const unsigned lds0 = (unsigned)(uintptr_t)shm; const lds_cptr shm3 = (lds_cptr)shm;
    ALAS float* wsf = (ALAS float*)(shm3 + M2_WS) + wid * 64;
    const int le = lane;
    { const unsigned koff = (unsigned)((le >> 3) * kvp + (((le & 7) ^ ((4 * wid + (le >> 4)) & 7)) * 8)) * 2u, voff = (unsigned)((le >> 3) * kvp + (((le & 7) ^ (((le >> 4) & 1) * 4)) * 8)) * 2u;
      const bf16* kb = d.K + (long)(8 * wid) * kvp; const bf16* vb = d.V + (long)(8 * wid) * kvp;
#pragma unroll
      for (int t = 0; t < 4; ++t) { glds16s(kb + (long)(t * KVBLK) * kvp, koff, (unsigned)__builtin_amdgcn_readfirstlane(lds0 + M2_K + t * 8192 + wid * 1024));
                                    glds16s(vb + (long)(t * KVBLK) * kvp, voff, (unsigned)__builtin_amdgcn_readfirstlane(lds0 + M2_V + t * 8192 + wid * 1024)); } }
    const unsigned qvA = (unsigned)((le >> 3) * d.qpitch + (((le & 7) ^ (le >> 4)) * 8)) * 2u, qvB = qvA ^ 64u;
    const unsigned qdst = lds0 + LDS_Q + wid * 4096;
#define M2_DMA_Q(Qb) do { _Pragma("unroll") for (int j_ = 0; j_ < 4; ++j_) glds16s_nt((Qb) + (long)(wid * QBLK + 8 * j_) * d.qpitch, (j_ & 1) ? qvB : qvA, (unsigned)__builtin_amdgcn_readfirstlane(qdst + j_ * 1024)); } while (0)
    if (!d.qpre) M2_DMA_Q(d.Q);
    const lds_cptr kp0 = shm3 + M2_K + r32 * 128; const int kq0 = (((r32 >> 1) & 6) << 4) | ((hi ^ ((r32 >> 1) & 1)) << 4);
    const int vq_ = (lane & 15) >> 2, vsw_ = (vq_ >> 1) & 1;
    const int vb0_ = (int)(unsigned)(size_t)(shm3 + M2_V + (4 * hi + vq_) * 128 + ((lane >> 4) & 1) * 32 + (lane & 3) * 8 + vsw_ * 64);
    const int vb1_ = (int)(unsigned)(size_t)(shm3 + M2_V + (4 * hi + vq_) * 128 + ((lane >> 4) & 1) * 32 + (lane & 3) * 8 + (1 - vsw_) * 64);
    asm volatile("s_waitcnt vmcnt(0)\n\ts_barrier" ::: "memory");
    unsigned pendq = 0u;
#pragma unroll 1
    for (int blk = 0; blk < 2; ++blk) {
        int blk_ = __builtin_amdgcn_readfirstlane(blk); asm volatile("" : "+s"(blk_));
        bf16x8 qr[4];
#pragma unroll
        for (int d0 = 0; d0 < 4; ++d0) qr[d0] = *(const ALAS bf16x8*)(shm3 + LDS_Q + wid * 4096 + r32 * 128 + ((32 * d0) ^ kq0));
        u32x4 g4[4];
        asm volatile("s_waitcnt lgkmcnt(0)" ::: "memory");
        if (blk_ == 0) { M2_DMA_Q(d.Q + (long)QB * d.qpitch);
            if (tid == 0 && d.qctr) pendq = __hip_atomic_fetch_add(d.qctr, 1u, __ATOMIC_RELAXED, __HIP_MEMORY_SCOPE_AGENT); }
        float l_reg = 0.f; f32x16 o[2]; o[0] = f32x16{}; o[1] = f32x16{};
#pragma unroll
        for (int t = 0; t < 4; ++t) {
            if (t == 3) { const bf16* gw = d.gate + (long)(blk_ * QB + wid * QBLK) * d.gpitch;
#pragma unroll
              for (int i = 0; i < 4; ++i) g4[i] = __builtin_nontemporal_load((const u32x4*)(gw + (long)(i * 8 + (le >> 3)) * d.gpitch + (le & 7) * 8)); }
            bf16x8 kf[8]; kload8(kf, kp0 + t * 8192, kq0);
            f32x16 s0, s1;
#pragma unroll
            for (int r = 0; r < 16; ++r) { s0[r] = d.negB; s1[r] = d.negB; }
#define M2_MFMA(a, b, c) __builtin_amdgcn_mfma_f32_32x32x16_bf16(a, b, c, 0, 0, 0)
            __builtin_amdgcn_s_setprio(1);
            s0 = M2_MFMA(kf[0], qr[0], s0); s1 = M2_MFMA(kf[1], qr[0], s1); s0 = M2_MFMA(kf[2], qr[1], s0); s1 = M2_MFMA(kf[3], qr[1], s1);
            s0 = M2_MFMA(kf[4], qr[2], s0); s1 = M2_MFMA(kf[5], qr[2], s1); s0 = M2_MFMA(kf[6], qr[3], s0); s1 = M2_MFMA(kf[7], qr[3], s1);
            __builtin_amdgcn_s_setprio(0);
            __builtin_amdgcn_sched_barrier(0);
            float sacc = 0.f;
#pragma unroll
            for (int r = 0; r < 16; ++r) { s0[r] = __builtin_amdgcn_exp2f(s0[r]); s1[r] = __builtin_amdgcn_exp2f(s1[r]); sacc += s0[r]; sacc += s1[r]; }
            l_reg += sacc;
            u32x4 pw0, pw1, pw2, pw3;
#define M2_PKW(P, B) cvtpk_s(P[B], P[B + 1])
            pw0 = (u32x4){M2_PKW(s0, 0), M2_PKW(s0, 2), M2_PKW(s0, 4), M2_PKW(s0, 6)}; pw1 = (u32x4){M2_PKW(s0, 8), M2_PKW(s0, 10), M2_PKW(s0, 12), M2_PKW(s0, 14)};
            pw2 = (u32x4){M2_PKW(s1, 0), M2_PKW(s1, 2), M2_PKW(s1, 4), M2_PKW(s1, 6)}; pw3 = (u32x4){M2_PKW(s1, 8), M2_PKW(s1, 10), M2_PKW(s1, 12), M2_PKW(s1, 14)};
            __builtin_amdgcn_sched_barrier(0);
#pragma unroll
            for (int d0 = 0; d0 < 2; ++d0) { s16x4 lo[4], hh[4];
#pragma unroll
                for (int ks = 0; ks < 4; ++ks) { const lds_cptr vq__ = (lds_cptr)(size_t)(unsigned)((d0 ? vb1_ : vb0_) + t * 8192 + ks * 2048); lo[ks] = vtr(vq__); hh[ks] = vtr(vq__ + 1024); }
#define M2_PK(k) (bf16x8){lo[k][0], lo[k][1], lo[k][2], lo[k][3], hh[k][0], hh[k][1], hh[k][2], hh[k][3]}
                __builtin_amdgcn_s_setprio(1);
                o[d0] = M2_MFMA(__builtin_bit_cast(bf16x8, pw0), M2_PK(0), o[d0]); o[d0] = M2_MFMA(__builtin_bit_cast(bf16x8, pw1), M2_PK(1), o[d0]);
                o[d0] = M2_MFMA(__builtin_bit_cast(bf16x8, pw2), M2_PK(2), o[d0]); o[d0] = M2_MFMA(__builtin_bit_cast(bf16x8, pw3), M2_PK(3), o[d0]);
                __builtin_amdgcn_s_setprio(0);
                __builtin_amdgcn_sched_barrier(0);
            }
        }
        { auto rr = __builtin_amdgcn_permlane32_swap(__float_as_uint(l_reg), __float_as_uint(l_reg), false, false); l_reg = __uint_as_float(rr[0]) + __uint_as_float(rr[1]); }
        if (hi == 0) wsf[32 + r32] = l_reg; asm volatile("s_waitcnt lgkmcnt(0)" ::: "memory");
        float rli[16];
#pragma unroll
        for (int r = 0; r < 16; ++r) rli[r] = __builtin_amdgcn_rcpf(wsf[32 + crow(r, hi)]);
        { __hip_bfloat16* stg = (__hip_bfloat16*)(shm + M2_OST) + wid * 2048;
#pragma unroll
          for (int r = 0; r < 16; ++r) { const int orow = crow(r, hi);
#pragma unroll
            for (int d0 = 0; d0 < 2; ++d0) stg[orow * 64 + d0 * 32 + r32] = __float2bfloat16(o[d0][r] * rli[r]); }
          asm volatile("s_waitcnt lgkmcnt(0)" ::: "memory");
          bf16* ow = d.O + (long)(blk_ * QB + wid * QBLK) * d.opitch;
          asm volatile("s_waitcnt vmcnt(0)" ::: "memory");
#pragma unroll
          for (int i = 0; i < 4; ++i) { const int row = i * 8 + (le >> 3), ch = le & 7; const u32x4 v = *(const u32x4*)(stg + row * 64 + ch * 8);
            const u32x4 g = g4[i];
            u32x4 w; w.x = mul_bf16x2(v.x, g.x); w.y = mul_bf16x2(v.y, g.y); w.z = mul_bf16x2(v.z, g.z); w.w = mul_bf16x2(v.w, g.w);
            st16_wt(ow + (long)row * d.opitch + ch * 8, w); }
          asm volatile("s_waitcnt lgkmcnt(0)" ::: "memory"); }
    }
    asm volatile("s_waitcnt vmcnt(0)" ::: "memory");
    if (tid == 0 && d.qctr) *(volatile ALAS unsigned*)(shm3 + d.hookQ) = pendq;
    asm volatile("s_waitcnt lgkmcnt(0)\n\ts_barrier" ::: "memory");
#undef M2_DMA_Q
#undef M2_MFMA
#undef M2_PKW
#undef M2_PK
}
}


constexpr int NWAVES = 8;
#ifndef MK_N_LAUNCHES
#define MK_N_LAUNCHES 1
#endif
constexpr int N_LAUNCHES = MK_N_LAUNCHES;
constexpr int N_PHASES = 4;
#ifndef PROBE_REP
#define PROBE_REP -1
#endif
#ifndef PROBE_MODE
#define PROBE_MODE -1
#endif
#ifndef PROBE_PREFIX
#define PROBE_PREFIX 0
#endif
#ifndef PROBE_FUSED
#define PROBE_FUSED -1
#endif
#ifndef PROBE_P1
#define PROBE_P1 -1
#endif
#ifndef FUSE23
#define FUSE23 ((MK_N_LAUNCHES == 1) && (PROBE_PREFIX == 0))
#endif

constexpr int BATCH = 8, SEQ = 4096, DMODEL = 1024, MROWS = BATCH * SEQ;
constexpr int INW = 3080;
constexpr int NPJ = 3072;
constexpr int C_UA = 0, C_GA = 256, C_QB = 512, C_KB = 1024, C_VB = 1536, C_GB = 2048, C_QM = 2560, C_GM = 2816;
constexpr int NMEM = 256, MEMROWS = BATCH * NMEM, MEMW = 256;
constexpr int FOXH = 8, MEMH = 4;
constexpr float EPS = 1e-6f, LOG2E = 1.4426950408889634f, C2 = 0.125f * 1.4426950408889634f;

constexpr size_t MiB = 1u << 20;
constexpr size_t WS_CTL = 0, CTL_ZERO_BYTES = 131072;
constexpr size_t WS_WIN = 1 * MiB;
constexpr size_t WS_WO = 8 * MiB;
constexpr size_t WS_WKV = 10 * MiB;
constexpr size_t WS_WP = 11 * MiB;
constexpr size_t WS_MN = 12 * MiB;
constexpr size_t WS_KM = 16 * MiB;
constexpr size_t WS_VM = 17 * MiB;
constexpr size_t WS_GLOC = 18 * MiB;
constexpr size_t WS_T = 19 * MiB;
constexpr size_t WS_G = 20 * MiB;
constexpr size_t WS_RMS = 22 * MiB;
constexpr size_t WS_XN = 32 * MiB;
constexpr size_t WS_PJ = 96 * MiB;
constexpr size_t WS_MIX = 288 * MiB;
constexpr size_t WS_DUMMY = 352 * MiB;
constexpr size_t WS_DUMMY2 = 384 * MiB;
constexpr size_t WS_END = 512 * MiB;
constexpr int CW_BAR = 1024;
constexpr int CW_QUEUE = 8192;
constexpr int CW_READY = 15872, CW_CLAIM = CW_READY + 128;
constexpr unsigned PANEL_NEED = 14u;
#ifndef GEMM_STAGGER_US
#define GEMM_STAGGER_US 0
#endif
#ifndef GEMM_QUOTA
#define GEMM_QUOTA 0
#endif
constexpr size_t WS_T0 = 21 * MiB;
constexpr int NFOXU = BATCH * FOXH * (SEQ / 256), NMEMU = BATCH * MEMH * (SEQ / 256), NPOOLU = MROWS / 128, NUNITS = NFOXU + NMEMU + NPOOLU;
constexpr float PRUNE_LOG2 = 32.0f;

constexpr int RING_BYTES = 151552, LDSCTL_OFF = RING_BYTES, MISC_OFF = LDSCTL_OFF + 320, LDS_BYTES = 155648;
static_assert(attn::LDS_BYTES <= attn::LDS_GZ && pg8::STAGE_BYTES <= attn::LDS_GZ && attn::LDS_GZ + 1024 + 4096 <= RING_BYTES, "phase scratch fits the phase region");

#define GAS __attribute__((address_space(1)))
#define LAS __attribute__((address_space(3)))
typedef unsigned short bf16;
typedef unsigned v4u __attribute__((ext_vector_type(4)));
typedef unsigned v2u __attribute__((ext_vector_type(2)));
typedef float f32x4 __attribute__((ext_vector_type(4)));
typedef short bf16x8 __attribute__((ext_vector_type(8)));
typedef GAS unsigned gu32;
#define RLX_AGENT __ATOMIC_RELAXED, __HIP_MEMORY_SCOPE_AGENT
#define LDS_WAIT() asm volatile("s_waitcnt lgkmcnt(0)" ::: "memory")
__device__ __forceinline__ unsigned f2bf(float f) { unsigned u = __builtin_bit_cast(unsigned, f); return (u + 0x7fffu + ((u >> 16) & 1u)) >> 16; }
__device__ __forceinline__ unsigned pk2(float lo, float hi) { return f2bf(lo) | (f2bf(hi) << 16); }
__device__ __forceinline__ float bf2f(unsigned short b) { return __uint_as_float((unsigned)b << 16); }

#define XB_TMO      128
#define XB_XCNT(j)  (256  + 64 * (j))
#define XB_XSUB(j)  (1280 + 64 * (j))
#define XB_XGEN(j)  (2304 + 64 * (j))
#define XB_TOP      3328
#define XB_TOPGEN   3392
#define XCD_BAR_WORDS 3456
#define XB_SPIN_CAP (1u << 18)

__device__ __forceinline__ unsigned xb_ld(unsigned* p)              { return __hip_atomic_load(p, __ATOMIC_RELAXED, __HIP_MEMORY_SCOPE_AGENT); }
__device__ __forceinline__ unsigned xb_add(unsigned* p, unsigned v) { return __hip_atomic_fetch_add(p, v, __ATOMIC_RELAXED, __HIP_MEMORY_SCOPE_AGENT); }
__device__ __forceinline__ unsigned xb_xcc_id() { return (unsigned)__builtin_amdgcn_s_getreg((3 << 11) | 20) & 0xFu; }
#define XB_SPIN(cond, bar) do { unsigned _sp = 0; while (cond) { __builtin_amdgcn_s_sleep(1); \
    if ((++_sp & 255u) == 0u) { if (xb_ld(&(bar)[XB_TMO])) break; if (_sp > XB_SPIN_CAP) { atomicAdd(&(bar)[XB_TMO], 1u); break; } } } } while (0)

struct XcdBarrier {
    unsigned* bar; unsigned x;
    volatile LAS unsigned* st;
};

__device__ __forceinline__ XcdBarrier xcd_barrier_post(unsigned* bar, volatile LAS unsigned* st) {
    XcdBarrier b; b.bar = bar; b.x = xb_xcc_id(); b.st = st;
    if (threadIdx.x == 0) (void)xb_add(&bar[XB_XCNT(b.x)], 1u);
    return b;
}
__device__ __forceinline__ void xcd_barrier_complete(unsigned* bar, unsigned x, unsigned& nloc, unsigned& nx) {
    const unsigned G = gridDim.x * gridDim.y * gridDim.z;
    unsigned sum, cnt, mine, sp = 0u;
    for (;;) {
        sum = 0u; cnt = 0u; mine = 0u;
#pragma unroll
        for (unsigned j = 0; j < 16; ++j) { const unsigned c = xb_ld(&bar[XB_XCNT(j)]); sum += c; cnt += (c > 0u) ? 1u : 0u; mine = (j == x) ? c : mine; }
        if (sum == G) break;
        __builtin_amdgcn_s_sleep(1);
        if ((++sp & 255u) == 0u) { if (xb_ld(&bar[XB_TMO])) break; if (sp > XB_SPIN_CAP) { atomicAdd(&bar[XB_TMO], 1u); break; } }
    }
    nloc = mine > 0u ? mine : 1u; nx = cnt > 0u ? cnt : 1u;
}

__device__ __forceinline__ void xcd_barrier(const XcdBarrier& b) {
    asm volatile("s_waitcnt vmcnt(0)" ::: "memory");
    __syncthreads();
    if (threadIdx.x == 0) {
        unsigned* bar = b.bar;
        __builtin_amdgcn_s_waitcnt(0);
        unsigned nloc = b.st[0], nx = b.st[1];
        if (nloc == 0u) { xcd_barrier_complete(bar, b.x, nloc, nx); b.st[0] = nloc; b.st[1] = nx; }
        const unsigned old = xb_add(&bar[XB_XSUB(b.x)], 1u);
        const unsigned gen = old / nloc;
        if (old + 1u == (gen + 1u) * nloc) {
            __builtin_amdgcn_fence(__ATOMIC_RELEASE, "agent");
            asm volatile("s_waitcnt vmcnt(0)" ::: "memory");
            const unsigned og = xb_add(&bar[XB_TOP], 1u);
            const unsigned tg = og / nx;
            if (og + 1u == (tg + 1u) * nx) xb_add(&bar[XB_TOPGEN], 1u);
            else XB_SPIN(xb_ld(&bar[XB_TOPGEN]) == tg, bar);
            __builtin_amdgcn_fence(__ATOMIC_ACQUIRE, "agent");
            xb_add(&bar[XB_XGEN(b.x)], 1u);
            asm volatile("s_waitcnt vmcnt(0)" ::: "memory");
        } else {
            XB_SPIN(xb_ld(&bar[XB_XGEN(b.x)]) == gen, bar);
            __builtin_amdgcn_fence(__ATOMIC_ACQUIRE, "agent");
            asm volatile("s_waitcnt vmcnt(0)" ::: "memory");
        }
    }
    __syncthreads();
}


__device__ __forceinline__ float dpp_f(float v, int ctrl_sel) {
    const int x = __builtin_bit_cast(int, v); int r;
    switch (ctrl_sel) { case 0: r = __builtin_amdgcn_update_dpp(0, x, 0xB1, 0xF, 0xF, true); break;
                        case 1: r = __builtin_amdgcn_update_dpp(0, x, 0x4E, 0xF, 0xF, true); break;
                        case 2: r = __builtin_amdgcn_update_dpp(0, x, 0x141, 0xF, 0xF, true); break;
                        default: r = __builtin_amdgcn_update_dpp(0, x, 0x140, 0xF, 0xF, true); break; }
    return __builtin_bit_cast(float, r);
}
__device__ __forceinline__ float row16_sum(float v) { v += dpp_f(v, 0); v += dpp_f(v, 1); v += dpp_f(v, 2); v += dpp_f(v, 3); return v; }
__device__ __forceinline__ float rows4_sum(float v) {
    const int x = __builtin_bit_cast(int, v);
    return (__builtin_bit_cast(float, __builtin_amdgcn_readlane(x, 0)) + __builtin_bit_cast(float, __builtin_amdgcn_readlane(x, 16))) +
           (__builtin_bit_cast(float, __builtin_amdgcn_readlane(x, 32)) + __builtin_bit_cast(float, __builtin_amdgcn_readlane(x, 48)));
}
__device__ __forceinline__ float wave_sum(float v) { return rows4_sum(row16_sum(v)); }
__device__ __forceinline__ float wave_max(float v) {
#pragma unroll
    for (int o = 1; o < 64; o <<= 1) v = fmaxf(v, __shfl_xor(v, o));
    return v;
}
template <bool SCALE>
__device__ __forceinline__ void transpose_item(const float* W, int ldw, int n0s, bf16* WT, int ldt, int n0d, int k0, LAS float* scr, int lane, const float* gk = nullptr) {
    float tv[32];
#pragma unroll
    for (int i = 0; i < 32; ++i) tv[i] = __builtin_nontemporal_load(&W[(size_t)(k0 + 2 * i + (lane >> 5)) * ldw + n0s + (lane & 31)]);
    if (SCALE) {
#pragma unroll
        for (int i = 0; i < 32; ++i) tv[i] *= gk[k0 + 2 * i + (lane >> 5)];
    }
#pragma unroll
    for (int i = 0; i < 32; ++i) scr[(2 * i + (lane >> 5)) * 33 + (lane & 31)] = tv[i];
    LDS_WAIT(); asm volatile("" ::: "memory");
    const int c = lane & 7;
#pragma unroll
    for (int j = 0; j < 4; ++j) { const int n = (lane >> 3) + 8 * j; const LAS float* s = scr + (8 * c) * 33 + n;
        v4u o; o.x = pk2(s[0 * 33], s[1 * 33]); o.y = pk2(s[2 * 33], s[3 * 33]); o.z = pk2(s[4 * 33], s[5 * 33]); o.w = pk2(s[6 * 33], s[7 * 33]);
        *(GAS v4u*)(WT + (size_t)(n0d + n) * ldt + k0 + 8 * c) = o; }
    LDS_WAIT(); asm volatile("" ::: "memory");
}

__device__ __forceinline__ float logit_bound(const float* ga, const float* gb, int lane) {
    const float v = wave_max(fabsf(ga[lane] * gb[lane]));
    return __uint_as_float(__builtin_amdgcn_readfirstlane(__float_as_uint(8.0f * LOG2E * v * 1.02f + 0.5f)));
}
typedef float pg8_f32x2_t __attribute__((ext_vector_type(2)));
struct Args { const float* in[14]; float* out; unsigned char* ws; int ph_lo, ph_hi; int ulo, uhi, qw, sub; int pmode, li; };

__device__ __forceinline__ void phase0(const Args& a, LAS unsigned char* lds, int tid, int lane, int wave) {
    const int blk = blockIdx.x, G = gridDim.x;
    unsigned char* ws = a.ws;
    const float* x = a.in[0]; const float* mem = a.in[1]; const float* norm_g = a.in[2]; const float* w_in = a.in[3]; const float* b_f = a.in[4];
    const float* w_pool = a.in[5]; const float* pool_scale = a.in[6]; const float* mem_norm_g = a.in[9]; const float* w_mem_kv = a.in[10]; const float* w_out = a.in[13];
    LAS float* WfT = (LAS float*)lds;
    LAS float* lf = (LAS float*)(lds + 32768);
    LAS float* scr = (LAS float*)(lds + 40960 + wave * 8448);
    { float wv[16];
#pragma unroll
      for (int q = 0; q < 16; ++q) { const int idx = tid + 512 * q; wv[q] = w_in[(size_t)(idx >> 3) * INW + 2048 + (idx & 7)]; }
#pragma unroll
      for (int q = 0; q < 16; ++q) { const int idx = tid + 512 * q; WfT[(idx & 7) * 1024 + (idx >> 3)] = wv[q]; } }
    { const int gt = blk * 512 + tid; if (gt < 16384) { const int g = gt >> 12, e = (gt >> 6) & 63, c = gt & 63;
        ((bf16*)(ws + WS_WP))[gt] = (bf16)f2bf(w_pool[g * 4096 + c * 64 + e] * pool_scale[g * 64 + e]); } }
    { const int gw = blk * NWAVES + wave, NGW = G * NWAVES;
      constexpr int I_IN = 96 * 16, I_O = 32 * 16, I_KV = 16 * 16;
      for (int it = gw; it < I_IN + I_O + I_KV; it += NGW) {
          int r = it;
          if (r < I_IN) { const int lbg = r % 96, kb = r / 96; const int j0 = 32 * lbg, n0s = j0 + (j0 >= 2048 ? 8 : 0);
              const int pn = j0 >> 8, lb = (j0 & 255) >> 5, pb = 4 * (lb & 1) + (lb >> 1);
              transpose_item<true>(w_in, INW, n0s, (bf16*)(ws + WS_WIN), DMODEL, 256 * pn + 32 * pb, 64 * kb, scr, lane, norm_g); continue; }
          r -= I_IN;
          if (r < I_O) { const int nb = r % 32, kb = r / 32; transpose_item<false>(w_out, DMODEL, 32 * nb, (bf16*)(ws + WS_WO), DMODEL, 32 * nb, 64 * kb, scr, lane); continue; }
          r -= I_O;
          { const int nb = r % 16, kb = r / 16; transpose_item<false>(w_mem_kv, 512, 32 * nb, (bf16*)(ws + WS_WKV), DMODEL, 32 * nb, 64 * kb, scr, lane); }
      } }
    __syncthreads();
    f32x4 gn[4];
#pragma unroll
    for (int j = 0; j < 4; ++j) gn[j] = ((const f32x4*)norm_g)[lane + 64 * j];
    const float bfl = b_f[lane & 7];
    f32x4 wfr[8][4];
#pragma unroll
    for (int jj = 0; jj < 8; ++jj)
#pragma unroll
        for (int j = 0; j < 4; ++j) wfr[jj][j] = *(const LAS f32x4*)(WfT + jj * 1024 + 4 * lane + 256 * j);
    for (int rb = blk; rb * 128 < MROWS; rb += G) {
        f32x4 vn[4];
        { const GAS f32x4* xr = (const GAS f32x4*)(x + ((size_t)rb * 128 + 16 * wave) * DMODEL) + lane;
#pragma unroll
          for (int j = 0; j < 4; ++j) vn[j] = __builtin_nontemporal_load(&xr[64 * j]); }
        asm volatile("" :: "v"(vn[0]), "v"(vn[1]), "v"(vn[2]), "v"(vn[3]));
        for (int i = 0; i < 16; ++i) {
            const int rl = 16 * wave + i; const size_t row = (size_t)rb * 128 + rl;
            f32x4 v[4]; float ss = 0.f;
#pragma unroll
            for (int j = 0; j < 4; ++j) { v[j] = vn[j]; ss = fmaf(v[j].x, v[j].x, ss); ss = fmaf(v[j].y, v[j].y, ss); ss = fmaf(v[j].z, v[j].z, ss); ss = fmaf(v[j].w, v[j].w, ss); }
            if (i < 15) { const GAS f32x4* xr = (const GAS f32x4*)(x + (row + 1) * DMODEL) + lane;
#pragma unroll
                for (int j = 0; j < 4; ++j) vn[j] = __builtin_nontemporal_load(&xr[64 * j]); }
            const float rms = __builtin_amdgcn_sqrtf(wave_sum(ss) * (1.0f / DMODEL) + EPS), rstd = __builtin_amdgcn_rcpf(rms);
#pragma unroll
            for (int j = 0; j < 4; ++j) v[j] = v[j] * rstd;
            if (lane == 0) ((float*)(ws + WS_RMS))[row] = rms;
            GAS v2u* o8 = (GAS v2u*)((bf16*)(ws + WS_XN) + row * DMODEL) + lane;
#pragma unroll
            for (int j = 0; j < 4; ++j) { v2u w; w.x = attn::cvtpk_s(v[j].x, v[j].y); w.y = attn::cvtpk_s(v[j].z, v[j].w);
              __hip_atomic_store((GAS unsigned long long*)&o8[64 * j], ((unsigned long long)w.y << 32) | w.x, __ATOMIC_RELAXED, __HIP_MEMORY_SCOPE_AGENT); }
#pragma unroll
            for (int j = 0; j < 4; ++j) v[j] = v[j] * gn[j];
            float pj[8];
#pragma unroll
            for (int jj = 0; jj < 8; ++jj) { float p; pg8_f32x2_t p2 = {0.f, 0.f};
#pragma unroll
                for (int j = 0; j < 4; ++j) { const f32x4 w = wfr[jj][j]; p2 = __builtin_elementwise_fma(v[j].xy, w.xy, p2); p2 = __builtin_elementwise_fma(v[j].zw, w.zw, p2); } p = p2.x + p2.y;
                pj[jj] = row16_sum(p); }
            float fz = 0.f;
#pragma unroll
            for (int jj = 0; jj < 8; ++jj) { const float t = rows4_sum(pj[jj]); if (lane == jj) fz = t; }
            if (lane < 8) { const float z = fz + bfl; lf[rl * 8 + lane] = fminf(z, 0.f) - log1pf(expf(-fabsf(z))); }
        }
        __syncthreads();
        { const int h = wave; const float p0 = lf[(2 * lane) * 8 + h], p1 = lf[(2 * lane + 1) * 8 + h]; const float s = p0 + p1; float inc = s;
#pragma unroll
          for (int o = 1; o < 64; o <<= 1) { const float t = __shfl_up(inc, o); if (lane >= o) inc += t; }
          const float exc = inc - s; float* gl = (float*)(ws + WS_GLOC) + ((size_t)rb * 128) * 8;
          gl[(2 * lane) * 8 + h] = exc + p0; gl[(2 * lane + 1) * 8 + h] = exc + p0 + p1;
          if (lane == 63) ((float*)(ws + WS_T))[rb * 8 + h] = inc; }
        __syncthreads();
    }
#pragma unroll
    for (int j = 0; j < 4; ++j) gn[j] = ((const f32x4*)mem_norm_g)[lane + 64 * j];
    for (int row = blk * NWAVES + wave; row < MEMROWS; row += G * NWAVES) {
        const GAS f32x4* xr = (const GAS f32x4*)(mem + (size_t)row * DMODEL) + lane;
        f32x4 v[4]; float ss = 0.f;
#pragma unroll
        for (int j = 0; j < 4; ++j) { v[j] = xr[64 * j]; ss += (v[j].x * v[j].x + v[j].y * v[j].y) + (v[j].z * v[j].z + v[j].w * v[j].w); }
        const float rstd = 1.0f / sqrtf(wave_sum(ss) * (1.0f / DMODEL) + EPS);
        GAS v2u* o8 = (GAS v2u*)((bf16*)(ws + WS_MN) + (size_t)row * DMODEL) + lane;
#pragma unroll
        for (int j = 0; j < 4; ++j) { const f32x4 y = v[j] * rstd * gn[j]; v2u w; w.x = pk2(y.x, y.y); w.y = pk2(y.z, y.w); o8[64 * j] = w; }
    }
}

__device__ __forceinline__ void phase1_pre(const Args& a, LAS unsigned char* lds, int tid, int lane, int wave) {
    unsigned char* ws = a.ws; const int G = gridDim.x;
    LAS float* red = (LAS float*)lds;
    LAS float* offs = (LAS float*)(lds + 1024);
    for (int rb = blockIdx.x; rb * 128 < MROWS; rb += G) {
        const int b = rb >> 5;
        if (tid < 256) { const int cr = tid >> 3, h = tid & 7, cb = 32 * b + cr; red[tid] = (cb < rb) ? ((const float*)(ws + WS_T))[cb * 8 + h] : 0.f; }
        __syncthreads();
        if (tid < 8) { float s = 0.f; for (int cr = 0; cr < 32; ++cr) s += red[cr * 8 + tid]; offs[tid] = s; }
        __syncthreads();
        for (int e = tid; e < 1024; e += 512) { const int r = e >> 3, h = e & 7;
            ((float*)(ws + WS_G))[(size_t)(b * 8 + h) * SEQ + 128 * (rb & 31) + r] = (((const float*)(ws + WS_GLOC))[((size_t)rb * 128 + r) * 8 + h] + offs[h]) * LOG2E; }
        __syncthreads();
    }
    if (wave >= 4) {
        const float Bf = logit_bound(a.in[7], a.in[8], lane); const float thr = -(PRUNE_LOG2 + 2.0f * Bf);
        for (int u = blockIdx.x * 4 + (wave - 4); u < NFOXU; u += G * 4) {
            const int bh = u >> 4, qb = u & 15, b = bh >> 3, h = bh & 7;
            const float tv = (lane < 32) ? ((const float*)(ws + WS_T))[(32 * b + lane) * 8 + h] : 0.f; float inc = tv;
#pragma unroll
            for (int o = 1; o < 32; o <<= 1) { const float t = __shfl_up(inc, o); if (lane >= o) inc += t; }
            const float exc = inc - tv;
            const float* gl = (const float*)(ws + WS_GLOC) + (size_t)b * SEQ * 8 + h;
            const int q0 = 256 * qb, sk = 64 * lane + 63;
            const float gq = (gl[(size_t)q0 * 8] + __shfl(exc, q0 >> 7)) * LOG2E;
            const float gs = (gl[(size_t)sk * 8] + __shfl(exc, sk >> 7)) * LOG2E;
            const unsigned long long m = __ballot(lane < 4 * qb && (gq - gs) < thr);
            if (lane == 0) ((int*)(ws + WS_T0))[u] = (int)__popcll(m) & ~1;
        }
    }
    const float* mem_k_g = a.in[12];
    __syncthreads();
    for (int u = blockIdx.x; u < 32 * 8; u += G) {
        const int rt = u >> 3, ct = u & 7; const int fr = lane & 15, fq = lane >> 4; const int wr4 = wave & 3, wc2 = wave >> 2;
        constexpr int MP = 1040;
        f32x4 acc[2]; acc[0] = (f32x4){0.f, 0.f, 0.f, 0.f}; acc[1] = acc[0];
        for (int half = 0; half < 2; ++half) {
            v4u ta[8], tb[8];
#pragma unroll
            for (int q = 0; q < 8; ++q) { const int c = tid + 512 * q, row = c >> 6, c16 = c & 63;
                ta[q] = *(const GAS v4u*)((const bf16*)(ws + WS_MN) + (size_t)(64 * rt + row) * DMODEL + 512 * half + 8 * c16);
                tb[q] = *(const GAS v4u*)((const bf16*)(ws + WS_WKV) + (size_t)(64 * ct + row) * DMODEL + 512 * half + 8 * c16); }
#pragma unroll
            for (int q = 0; q < 8; ++q) { const int c = tid + 512 * q, row = c >> 6, c16 = c & 63;
                *(LAS v4u*)(lds + row * MP + 16 * c16) = ta[q]; *(LAS v4u*)(lds + 64 * MP + row * MP + 16 * c16) = tb[q]; }
            __syncthreads();
#pragma unroll 4
            for (int ks = 0; ks < 16; ++ks) { const bf16x8 af = *(const LAS bf16x8*)(lds + (16 * wr4 + fr) * MP + 64 * ks + 16 * fq);
#pragma unroll
                for (int nb = 0; nb < 2; ++nb) { const bf16x8 bfr = *(const LAS bf16x8*)(lds + 64 * MP + (32 * wc2 + 16 * nb + fr) * MP + 64 * ks + 16 * fq);
                    acc[nb] = __builtin_amdgcn_mfma_f32_16x16x32_bf16(af, bfr, acc[nb], 0, 0, 0); } }
            __syncthreads();
        }
        LAS float* xs = (LAS float*)(lds + 128 * MP);
        float ssr[4];
#pragma unroll
        for (int reg = 0; reg < 4; ++reg) { float ss = acc[0][reg] * acc[0][reg] + acc[1][reg] * acc[1][reg];
            ss += __shfl_xor(ss, 1); ss += __shfl_xor(ss, 2); ss += __shfl_xor(ss, 4); ss += __shfl_xor(ss, 8); ssr[reg] = ss;
            if (fr == 0) xs[wc2 * 64 + 16 * wr4 + 4 * fq + reg] = ss; }
        __syncthreads();
        if (ct < 4) {
#pragma unroll
            for (int reg = 0; reg < 4; ++reg) { const int row = 16 * wr4 + 4 * fq + reg; const float r = 1.0f / sqrtf((ssr[reg] + xs[(wc2 ^ 1) * 64 + row]) * (1.0f / 64.0f) + EPS);
                bf16* o = (bf16*)(ws + WS_KM) + (size_t)(64 * rt + row) * MEMW + 64 * ct + 32 * wc2;
#pragma unroll
                for (int nb = 0; nb < 2; ++nb) o[16 * nb + fr] = (bf16)f2bf(acc[nb][reg] * r * mem_k_g[32 * wc2 + 16 * nb + fr]); }
        } else {
#pragma unroll
            for (int reg = 0; reg < 4; ++reg) { bf16* o = (bf16*)(ws + WS_VM) + (size_t)(64 * rt + 16 * wr4 + 4 * fq + reg) * MEMW + 64 * (ct - 4) + 32 * wc2;
#pragma unroll
                for (int nb = 0; nb < 2; ++nb) o[16 * nb + fr] = (bf16)f2bf(acc[nb][reg]); }
        }
        __syncthreads();
    }
    __syncthreads();
}

constexpr int DL_PITCH = 264, UB_OFF = 0, DL_OFF = 144 * 512, POOL_LDS = DL_OFF + 128 * DL_PITCH * 2;
__device__ __forceinline__ unsigned mulbf2(unsigned a, unsigned b) { return pk2(__uint_as_float(a << 16) * __uint_as_float(b << 16), __uint_as_float(a & 0xffff0000u) * __uint_as_float(b & 0xffff0000u)); }
__device__ __forceinline__ void pool_unit(const Args& a, int pu, LAS unsigned char* lds, int tid_, int lane_, int wave, int wt = 0) {
    int tid = tid_; asm volatile("" : "+v"(tid)); const int lane = tid & 63;
    unsigned char* ws = a.ws;
    const bf16* PJ = (const bf16*)(ws + WS_PJ);
    const int r0 = pu * 128, tpos0 = r0 & (SEQ - 1);
    v4u uv[9], gtv[8];
#pragma unroll
    for (int q = 0; q < 9; ++q) { const int c = tid + q * NWAVES * 64, row = c >> 5, ch = c & 31; const int tp = tpos0 - 16 + row;
        uv[q] = (v4u){0u, 0u, 0u, 0u}; if (tp >= 0) uv[q] = __builtin_nontemporal_load((const GAS v4u*)(PJ + (size_t)(r0 - 16 + row) * NPJ + C_UA + ch * 8)); }
    bf16x8 bfr[4][2];
    { const int g = wave >> 1, fr = lane & 15, fq = lane >> 4; const bf16* WpT = (const bf16*)(ws + WS_WP) + g * 4096;
#pragma unroll
      for (int cb = 0; cb < 4; ++cb)
#pragma unroll
        for (int ks = 0; ks < 2; ++ks) bfr[cb][ks] = *(const bf16x8*)(WpT + (16 * cb + fr) * 64 + 32 * ks + 8 * fq); }
#pragma unroll
    for (int q = 0; q < 8; ++q) { const int c = tid + q * NWAVES * 64, row = c >> 5, ch = c & 31; gtv[q] = __builtin_nontemporal_load((const GAS v4u*)(PJ + (size_t)(r0 + row) * NPJ + C_GA + ch * 8)); }
#pragma unroll
    for (int q = 0; q < 9; ++q) { const int c = tid + q * NWAVES * 64, row = c >> 5, ch = c & 31; *(LAS v4u*)(lds + UB_OFF + row * 512 + ch * 16) = uv[q]; }
    __syncthreads();
    {
        const int cp = tid & 127, rq = tid >> 7; const int g = cp >> 5, w = 2 << g;
        const LAS unsigned* ub = (const LAS unsigned*)(lds + UB_OFF) + cp;
        LAS unsigned* dl = (LAS unsigned*)(lds + DL_OFF) + cp;
        const int lr0 = 16 + 32 * rq, tq = tpos0 + 32 * rq; const float invw = 1.0f / (float)w;
        float s0 = 0.f, s1 = 0.f;
        for (int k = w - 1; k >= 1; --k) { const unsigned uu = ub[(lr0 - k) * 128]; s0 += __uint_as_float(uu << 16); s1 += __uint_as_float(uu & 0xffff0000u); }
#pragma unroll 4
        for (int i = 0; i < 32; ++i) {
            const unsigned uu = ub[(lr0 + i) * 128], uo = ub[(lr0 + i + 1 - w) * 128];
            const float c0 = __uint_as_float(uu << 16), c1 = __uint_as_float(uu & 0xffff0000u);
            s0 += c0; s1 += c1;
            const int t = tq + i; float m0, m1;
            if (t + 1 < w) { const float cnt = (float)(t + 1); m0 = s0 / cnt; m1 = s1 / cnt; } else { m0 = s0 * invw; m1 = s1 * invw; }
            dl[(32 * rq + i) * (DL_PITCH / 2)] = pk2(m0 - c0, m1 - c1);
            s0 -= __uint_as_float(uo << 16); s1 -= __uint_as_float(uo & 0xffff0000u);
        }
    }
    __syncthreads();
    {
        const int g = wave >> 1, rh = wave & 1, fr = lane & 15, fq = lane >> 4;
        const LAS unsigned char* dlb = (const LAS unsigned char*)(lds + DL_OFF);
        LAS unsigned short* yl = (LAS unsigned short*)(lds + UB_OFF);
#pragma unroll
        for (int rb = 0; rb < 4; ++rb) {
            f32x4 acc[4];
#pragma unroll
            for (int cb = 0; cb < 4; ++cb) acc[cb] = (f32x4){0.f, 0.f, 0.f, 0.f};
#pragma unroll
            for (int ks = 0; ks < 2; ++ks) { const bf16x8 af = *(const LAS bf16x8*)(dlb + (64 * rh + 16 * rb + fr) * (DL_PITCH * 2) + (64 * g + 32 * ks + 8 * fq) * 2);
#pragma unroll
                for (int cb = 0; cb < 4; ++cb) acc[cb] = __builtin_amdgcn_mfma_f32_16x16x32_bf16(af, bfr[cb][ks], acc[cb], 0, 0, 0); }
#pragma unroll
            for (int reg = 0; reg < 4; ++reg)
#pragma unroll
                for (int cb = 0; cb < 4; ++cb) yl[(64 * rh + 16 * rb + 4 * fq + reg) * DL_PITCH + 64 * g + 16 * cb + fr] = (unsigned short)f2bf(acc[cb][reg]);
        }
    }
    __syncthreads();
#pragma unroll
    for (int q = 0; q < 8; ++q) { const int c = tid + q * NWAVES * 64, row = c >> 5, ch = c & 31;
        const v4u y = *(const LAS v4u*)(lds + UB_OFF + row * (DL_PITCH * 2) + ch * 16);
        const v4u gt = gtv[q];
        v4u o; o.x = mulbf2(y.x, gt.x); o.y = mulbf2(y.y, gt.y); o.z = mulbf2(y.z, gt.z); o.w = mulbf2(y.w, gt.w);
        if (wt) attn::st16_wt((bf16*)(ws + WS_MIX) + (size_t)(r0 + row) * DMODEL + ch * 8, __builtin_bit_cast(attn::u32x4, o)); else *(GAS v4u*)((bf16*)(ws + WS_MIX) + (size_t)(r0 + row) * DMODEL + ch * 8) = o; }
    __syncthreads();
}

__global__ void __launch_bounds__(NWAVES * 64, 2) hymba_fwd(Args args) {
    extern __shared__ __attribute__((aligned(16))) unsigned char lds_raw[];
    LAS unsigned char* lds = (LAS unsigned char*)lds_raw;
    volatile LAS unsigned* MISC = (volatile LAS unsigned*)(lds + MISC_OFF);
    const int tid = threadIdx.x, lane = tid & 63, wave = __builtin_amdgcn_readfirstlane(tid >> 6);
    const int G = gridDim.x; const int bx = blockIdx.x; const int vcu = (G % 8 == 0) ? (bx % 8) * (G / 8) + bx / 8 : bx;
    unsigned char* ws = args.ws;
    gu32* ctl = (gu32*)(ws + WS_CTL);
    static_assert(POOL_LDS <= attn::LDS_GZ, "pool scratch fits the phase region");
    for (int u = tid; u < (LDS_BYTES - LDSCTL_OFF) / 4; u += NWAVES * 64) ((LAS unsigned*)(lds + LDSCTL_OFF))[u] = 0u;
    __syncthreads();
    XcdBarrier bar; bar.bar = (unsigned*)(ctl + CW_BAR) + args.li * XCD_BAR_WORDS; bar.x = 0; bar.st = nullptr;
    if (N_LAUNCHES == 1) bar = xcd_barrier_post((unsigned*)(ctl + CW_BAR) + args.li * XCD_BAR_WORDS, MISC + 8);
    const int lo = args.ph_lo, hi = args.ph_hi;
#define IN(k) (lo <= (k) && (k) < hi)
#define BOTH(k) (IN(k) && IN((k) + 1))

    if (IN(0)) { phase0(args, lds, tid, lane, wave); if (BOTH(0)) xcd_barrier(bar); }

    if (IN(1)) {
        const int late1 = __builtin_amdgcn_readfirstlane((bx >> 3) & 1);
        if (!late1) phase1_pre(args, lds, tid, lane, wave);
        if (!(args.sub & 4)) {
        pg8::Gemm g{(const pg8::bf16_t*)(ws + WS_XN), (const pg8::bf16_t*)(ws + WS_WIN), MROWS, NPJ, DMODEL};
        pg8::StaticOrder S; S.init(MROWS, NPJ, G, bx);
        pg8::EpiProj E{(pg8::bf16_t*)(ws + WS_PJ), NPJ, args.in[7], args.in[8], args.in[11], C2, args.pmode == 8 ? 1 : 0, (unsigned)(size_t)(lds + pg8::STAGE_BYTES)};
        static_assert(pg8::STAGE_BYTES + 8 * 2304 <= RING_BYTES, "epilogue staging above the stage buffers");
        pg8::gemm_phase<pg8::EpiProj, pg8::StaticOrder, true, true>(lds, g, S, E);
        }
        if (late1) { __syncthreads(); phase1_pre(args, lds, tid, lane, wave); }
        if (BOTH(1)) xcd_barrier(bar);
    }

    if (IN(2)) {
        __syncthreads();
        for (int u = tid; u < 256; u += NWAVES * 64) ((LAS unsigned*)(lds + attn::LDS_GZ))[u] = 0u;
        const float Bf = logit_bound(args.in[7], args.in[8], lane), Bm = logit_bound(args.in[11], args.in[12], lane);
        __syncthreads();
        const bf16* PJ = (const bf16*)(ws + WS_PJ); bf16* MIX = (bf16*)(ws + WS_MIX);
        volatile LAS unsigned* Q = MISC + 16;
        const unsigned xq = xb_xcc_id() & 7u;
        gu32* qbase = ctl + CW_QUEUE + 512 * args.qw; const gu32* t0tab = (const gu32*)(ws + WS_T0); const unsigned ilo = (unsigned)args.ulo, ilen = (unsigned)(args.uhi - args.ulo);
        constexpr unsigned QEND = 0xffffffffu;
#define FOX_TAB(i) ((((i) & 63) << 4) + 15 - ((i) >> 6))
#define QDECODE2(y, i) (((i) < 32u) ? (unsigned)NFOXU + (y) * 32u + (i) : (((((i) - 32u) >> 3) << 6) | (((((y) - (((i) - 32u) & 7u)) & 7u) << 3) | (((i) - 32u) & 7u))))
#define QDECODE(y, i) (((i) < 64u) ? (unsigned)NFOXU + (y) * 64u + (i) : (((((i) - 64u) >> 3) << 6) | (((((y) - (((i) - 64u) & 7u)) & 7u) << 3) | (((i) - 64u) & 7u))))
#define QPOP(dst) do { unsigned r_ = __hip_atomic_fetch_add(qbase + 64 * xq, 1u, RLX_AGENT); unsigned y_ = xq; \
            for (unsigned dy_ = 1; r_ >= ilen && dy_ < 8; ++dy_) { y_ = (xq + dy_) & 7u; r_ = __hip_atomic_fetch_add(qbase + 64 * y_, 1u, RLX_AGENT); } \
            dst = (r_ < ilen) ? QDECODE(y_, ilo + r_) : QEND; } while (0)
        if constexpr (FUSE23) {
            gu32* ready = ctl + CW_READY + 16384 * args.qw; const int pmode = args.pmode; volatile LAS unsigned* SEL = MISC + 32;
            static_assert(NFOXU == 2 * NWAVES * 64, "two table entries per thread");
            const unsigned tv0 = __hip_atomic_load(t0tab + tid, RLX_AGENT), tv1 = __hip_atomic_load(t0tab + tid + NWAVES * 64, RLX_AGENT);
            unsigned r0 = 0u; if (tid == 0 && pmode < 5) r0 = __hip_atomic_fetch_add(qbase + 64 * xq, 1u, RLX_AGENT);
            const int late_pool = __builtin_amdgcn_readfirstlane((pmode == 0 && ((vcu >> 4) & 1) == 0 && G == 256) ? 1 : 0);
            auto do_pool = [&]() {
                for (int pu = vcu; pu < NPOOLU; pu += G) { pool_unit(args, pu, lds, tid, lane, wave, 1);
                    asm volatile("s_waitcnt vmcnt(0)" ::: "memory"); __syncthreads(); if (tid == 0) __hip_atomic_fetch_add(ready + (pu >> 1), 1u, RLX_AGENT); } };
            if (!late_pool) do_pool();
#define OUT_UNIT(o, pm_, pn_) do { const int h_ = (o) >> 8, r_ = (o) & 255, pi_ = r_ >> 2; pn_ = r_ & 3; pm_ = (pi_ >> 3) * 16 + (h_ ? 7 - (pi_ & 7) : 15 - (pi_ & 7)); } while (0)
            int opm = -1; { const int o_ = vcu + (lane & 1) * G; if (tid < 2 && o_ < 512) { int pn_; OUT_UNIT(o_, opm, pn_); } }
            if (tid < 2) SEL[12 + tid] = 0u;
            LAS unsigned* t0l = (LAS unsigned*)(lds + attn::LDS_GZ + 1024);
            t0l[tid] = tv0; t0l[tid + NWAVES * 64] = tv1;
            if (pmode < 5) {
                if (tid == 0) { unsigned r_ = r0, y_ = xq;
                    for (unsigned dy_ = 1; r_ >= ilen && dy_ < 8; ++dy_) { y_ = (xq + dy_) & 7u; r_ = __hip_atomic_fetch_add(qbase + 64 * y_, 1u, RLX_AGENT); }
                    SEL[0] = (r_ < ilen) ? QDECODE2(y_, ilo + r_) : QEND; SEL[1] = 0u; }
                __syncthreads();
                auto nextq = [&](unsigned r) -> const bf16* {
                    if (r >= ilen) return nullptr;
                    const unsigned id = QDECODE2(xq, ilo + r);
                    if (id < (unsigned)NFOXU) { const int qb = 15 - (int)(id >> 6), bh = (int)(id & 63), b = bh >> 3, h = bh & 7; return PJ + ((size_t)b * SEQ + (size_t)qb * 256) * NPJ + C_QB + h * 64; }
                    const int idx = (int)id - NFOXU; const int b = idx >> 5, hm = (idx & 31) >> 3, qt = 2 * (idx & 7); return PJ + ((size_t)b * SEQ + (size_t)qt * 256) * NPJ + C_QM + hm * 64; };
                for (;;) {
                    const unsigned cur = SEL[0]; const unsigned qpre = SEL[1];
                    if (cur == QEND) break;
                    int pm_done, pm_done2 = -1; unsigned succ_q = 1u;
                    if (cur < (unsigned)NFOXU) {
                        attn::Desc d;
                        const int qb = 15 - (int)(cur >> 6), bh = (int)(cur & 63), b = bh >> 3, h = bh & 7; const size_t row0 = (size_t)b * SEQ + (size_t)qb * 256;
                        d.Q = PJ + row0 * NPJ + C_QB + h * 64; d.K = PJ + (size_t)b * SEQ * NPJ + C_KB + h * 64; d.V = PJ + (size_t)b * SEQ * NPJ + C_VB + h * 64;
                        d.gate = PJ + row0 * NPJ + C_GB + h * 64; d.O = MIX + row0 * DMODEL + 256 + h * 64; d.G = (const float*)(ws + WS_G) + (size_t)bh * SEQ;
                        d.kvpitch = NPJ; d.NT = 4 * qb + 4; d.t0 = (int)t0l[FOX_TAB(cur)]; d.causal = 1; d.q0 = qb * 256; d.negB = -Bf; pm_done = b * 16 + qb;
                        d.qpitch = NPJ; d.gpitch = NPJ; d.opitch = DMODEL; d.wt = 1; d.qpre = (int)qpre; d.dmaprobe = (pmode == 3) ? 1 : 0; d.qctr = (unsigned*)(qbase + 64 * xq); d.hookQ = (unsigned)(MISC_OFF + 96);
                        d.pendA = 0u; d.pendL = 0u; d.hookA = (unsigned)(MISC_OFF + 160); d.hookL = (unsigned)(MISC_OFF + 164);
                        attn::unit(d, (char*)lds_raw, nextq);
                    } else {
                        attn::MemDesc md;
                        const int idx = (int)cur - NFOXU; const int b = idx >> 5, hm = (idx & 31) >> 3, qt = 2 * (idx & 7); const size_t row0 = (size_t)b * SEQ + (size_t)qt * 256;
                        md.Q = PJ + row0 * NPJ + C_QM + hm * 64; md.gate = PJ + row0 * NPJ + C_GM + hm * 64;
                        md.O = MIX + row0 * DMODEL + 768 + hm * 64;
                        md.K = (const bf16*)(ws + WS_KM) + (size_t)b * NMEM * MEMW + hm * 64; md.V = (const bf16*)(ws + WS_VM) + (size_t)b * NMEM * MEMW + hm * 64;
                        md.qpitch = NPJ; md.gpitch = NPJ; md.opitch = DMODEL; md.kvpitch = MEMW; md.negB = -Bm; md.qpre = (int)qpre; md.qctr = (unsigned*)(qbase + 64 * xq); md.hookQ = (unsigned)(MISC_OFF + 96);
                        pm_done = b * 16 + qt; pm_done2 = pm_done + 1; succ_q = 0u;
                        attn::mem_unit2(md, (char*)lds_raw);
                    }
                    unsigned orv = 0u; if (opm >= 0) orv = __hip_atomic_load(ready + opm, RLX_AGENT);
                    unsigned qsn = 0xffffffffu; if (tid < 8) qsn = __hip_atomic_load(qbase + 64 * tid, RLX_AGENT);
                    asm volatile("s_waitcnt vmcnt(0)" ::: "memory");
                    if (opm >= 0) SEL[12 + tid] = (orv >= PANEL_NEED) ? 1u : 0u;
                    if (wave == 0) {
                        unsigned r = MISC[24], y = xq; const unsigned pre = (r < ilen) ? succ_q : 0u;
                        if (r >= ilen) {
                            unsigned m = (unsigned)(__ballot(qsn < ilen) & 0xffull) & ~(1u << xq);
                            r = 0xffffffffu;
                            while (m) {
                                const unsigned sh = (xq + 1u) & 7u, rot = ((m >> sh) | (m << (8u - sh))) & 0xffu;
                                y = (sh + (unsigned)__builtin_ctz(rot)) & 7u;
                                unsigned c = 0u; if (lane == 0) c = __hip_atomic_fetch_add(qbase + 64 * y, 1u, RLX_AGENT); c = (unsigned)__builtin_amdgcn_readfirstlane(c);
                                if (c < ilen) { r = c; break; }
                                m &= ~(1u << y); }
                        }
                        if (lane == 0) { SEL[1] = pre; SEL[0] = (r < ilen) ? QDECODE2(y, ilo + r) : QEND; } }
                    __syncthreads();
                    if (tid == 0) { __hip_atomic_fetch_add(ready + pm_done, 1u, RLX_AGENT); if (pm_done2 >= 0) __hip_atomic_fetch_add(ready + pm_done2, 1u, RLX_AGENT); }
                }
            }
            if (late_pool) { __syncthreads(); do_pool(); }
            if (pmode != 4 && pmode != 3) {
            __syncthreads();
            if (wave == 0) {
                if (pmode >= 5 && lane < 2) SEL[12 + lane] = 1u;
                __builtin_amdgcn_fence(__ATOMIC_ACQUIRE, "agent"); asm volatile("s_waitcnt vmcnt(0)" ::: "memory");
            }
            int it = 0;
            for (int o = vcu; o < 512; o += G, ++it) {
                int pm, pn; OUT_UNIT(o, pm, pn);
                __syncthreads();
                if (wave == 0 && !(it < 2 && SEL[12 + it] != 0u)) {
                    for (unsigned spin = 0; spin < (1u << 16); ++spin) {
                        if (__hip_atomic_load(ready + pm, RLX_AGENT) >= PANEL_NEED || pmode >= 5) break;
                        __builtin_amdgcn_s_sleep(32); }
                    __builtin_amdgcn_fence(__ATOMIC_ACQUIRE, "agent"); asm volatile("s_waitcnt vmcnt(0)" ::: "memory");
                }
                __syncthreads();
                pg8::Gemm g{(const pg8::bf16_t*)(ws + WS_MIX), (const pg8::bf16_t*)(ws + WS_WO), MROWS, DMODEL, DMODEL};
                pg8::OneUnit S{pm, pn};
                pg8::EpiResLds E{(const pg8::bf16_t*)(ws + WS_XN), (const float*)(ws + WS_RMS), (args.pmode >= 5) ? (float*)(ws + WS_DUMMY2) : args.out, DMODEL, (args.pmode == 6) ? 1 : (args.pmode == 7) ? 2 : 0};
                pg8::gemm_phase<pg8::EpiResLds, pg8::OneUnit, false, true>(lds, g, S, E);
            }
            }
        } else {
        if (args.sub & 1) {
        if (tid == 0) { unsigned u0, u1; QPOP(u0); QPOP(u1);
            Q[0] = u0; Q[1] = (u0 < (unsigned)NFOXU) ? __hip_atomic_load(t0tab + FOX_TAB(u0), RLX_AGENT) : 0u; Q[2] = u1; Q[3] = 0u; }
        __syncthreads();
        for (int k = 0;; ++k) {
            const unsigned cur = Q[2 * (k & 1)], ct0 = Q[2 * (k & 1) + 1], nxt = Q[2 * ((k + 1) & 1)];
            if (cur == QEND) break;
            unsigned pa = 0u, pl = 0u;
            if (tid == 0) { pa = __hip_atomic_fetch_add(qbase + 64 * xq, 1u, RLX_AGENT); if (nxt < (unsigned)NFOXU) pl = __hip_atomic_load(t0tab + FOX_TAB(nxt), RLX_AGENT); }
            const unsigned hookA = (unsigned)(MISC_OFF + 96), hookL = (unsigned)(MISC_OFF + 64 + 8 * ((k + 1) & 1) + 4);
            {
                attn::Desc d;
                if (cur < (unsigned)NFOXU) {
                    const int qb = 15 - (int)(cur >> 6), bh = (int)(cur & 63), b = bh >> 3, h = bh & 7; const size_t row0 = (size_t)b * SEQ + (size_t)qb * 256;
                    d.Q = PJ + row0 * NPJ + C_QB + h * 64; d.K = PJ + (size_t)b * SEQ * NPJ + C_KB + h * 64; d.V = PJ + (size_t)b * SEQ * NPJ + C_VB + h * 64;
                    d.gate = PJ + row0 * NPJ + C_GB + h * 64; d.O = MIX + row0 * DMODEL + 256 + h * 64; d.G = (const float*)(ws + WS_G) + (size_t)bh * SEQ;
                    d.kvpitch = NPJ; d.NT = 4 * qb + 4; d.t0 = (int)ct0; d.causal = 1; d.q0 = qb * 256; d.negB = -Bf;
                    if (args.pmode) { d.O = (bf16*)(ws + WS_DUMMY) + row0 * DMODEL + 256 + h * 64; if (args.pmode == 1) d.t0 = 0; if (args.pmode == 2) d.t0 = d.NT - 4; }
                } else {
                    const int idx = (int)cur - NFOXU; const int b = idx >> 6, hm = (idx >> 4) & 3, qt = idx & 15; const size_t row0 = (size_t)b * SEQ + (size_t)qt * 256;
                    d.Q = PJ + row0 * NPJ + C_QM + hm * 64; d.K = (const bf16*)(ws + WS_KM) + (size_t)b * NMEM * MEMW + hm * 64; d.V = (const bf16*)(ws + WS_VM) + (size_t)b * NMEM * MEMW + hm * 64;
                    d.gate = PJ + row0 * NPJ + C_GM + hm * 64; d.O = MIX + row0 * DMODEL + 768 + hm * 64; d.G = nullptr;
                    d.kvpitch = MEMW; d.NT = 4; d.t0 = 0; d.causal = 0; d.q0 = 0; d.negB = -Bm;
                }
                d.qpitch = NPJ; d.gpitch = NPJ; d.opitch = DMODEL; d.wt = 0; d.qpre = 0; d.dmaprobe = 0; d.qctr = nullptr; d.hookQ = 0u; d.pendA = pa; d.pendL = pl; d.hookA = hookA; d.hookL = hookL;
                attn::unit(d, (char*)lds_raw, [](unsigned) -> const bf16* { return nullptr; });
            }
            if (tid == 0) {
                unsigned r = MISC[24], y = xq;
                for (unsigned dy = 1; r >= ilen && dy < 8; ++dy) { y = (xq + dy) & 7u; r = __hip_atomic_fetch_add(qbase + 64 * y, 1u, RLX_AGENT); }
                Q[2 * (k & 1)] = (r < ilen) ? QDECODE(y, ilo + r) : QEND; }
            __syncthreads();
        }
        }
        __syncthreads();
        if (args.sub & 2) for (int pu = vcu; pu < NPOOLU; pu += G) pool_unit(args, pu, lds, tid, lane, wave);
        if (BOTH(2)) xcd_barrier(bar);
        }
#undef QPOP
#undef QDECODE
#undef QDECODE2
#undef FOX_TAB
    }

    if (!FUSE23 && IN(3)) {
        __syncthreads();
        pg8::Gemm g{(const pg8::bf16_t*)(ws + WS_MIX), (const pg8::bf16_t*)(ws + WS_WO), MROWS, DMODEL, DMODEL};
        pg8::StaticOrder S; S.init(MROWS, DMODEL, G, bx);
        pg8::EpiRes E{args.in[0], (args.pmode >= 5) ? (float*)(ws + WS_DUMMY2) : args.out, DMODEL, (args.pmode == 6) ? 1 : (args.pmode == 7) ? 2 : 0};
        pg8::gemm_phase<pg8::EpiRes, pg8::StaticOrder, true, true>(lds, g, S, E);
    }
#undef IN
#undef BOTH
}

extern "C" void kernel_launch(void* const* d_in, const int* in_sizes, int n_in, void* d_out, int out_size, void* d_ws, size_t ws_size, hipStream_t stream) {
    static int grid = 0;
    if (grid == 0) {
        if (n_in != 14 || in_sizes[0] != MROWS * DMODEL || out_size != MROWS * DMODEL || ws_size < WS_END) { fprintf(stderr, "kernel_launch: unexpected shapes (n_in %d, in0 %d, out %d, ws %zu); nothing launched\n", n_in, n_in > 0 ? in_sizes[0] : -1, out_size, ws_size); grid = -1; return; }
        int dev = 0, cus = 0, per_cu = 0;
        if (hipGetDevice(&dev) != hipSuccess || hipDeviceGetAttribute(&cus, hipDeviceAttributeMultiprocessorCount, dev) != hipSuccess) { fprintf(stderr, "kernel_launch: device query failed\n"); grid = -1; return; }
        if (hipFuncSetAttribute((const void*)hymba_fwd, hipFuncAttributeMaxDynamicSharedMemorySize, LDS_BYTES) != hipSuccess) { fprintf(stderr, "kernel_launch: hipFuncSetAttribute failed\n"); grid = -1; return; }
        if (hipOccupancyMaxActiveBlocksPerMultiprocessor(&per_cu, (const void*)hymba_fwd, NWAVES * 64, LDS_BYTES) != hipSuccess || per_cu < 1)
            fprintf(stderr, "kernel_launch: note: occupancy query reports %d workgroups per CU\n", per_cu);
        (void)hipGetLastError();
        grid = cus;
        if (grid > 256) grid = 256;
    }
    if (grid < 0) return;
    (void)hipMemsetAsync((char*)d_ws + WS_CTL, 0, CTL_ZERO_BYTES, stream);
    Args a{};
    for (int i = 0; i < 14; ++i) a.in[i] = (const float*)d_in[i];
    a.out = (float*)d_out; a.ws = (unsigned char*)d_ws;
    a.ulo = 0; a.uhi = (FUSE23 ? 160 : 192); a.qw = 0; a.sub = 3;
    if (N_LAUNCHES == 1) {
        if (PROBE_PREFIX > 0) { a.ph_lo = 0; a.ph_hi = PROBE_PREFIX; a.li = 1; a.qw = 1; hipLaunchKernelGGL(hymba_fwd, dim3(grid), dim3(NWAVES * 64), LDS_BYTES, stream, a); a.li = 0; a.qw = 0; }
        a.ph_lo = 0; a.ph_hi = N_PHASES; hipLaunchKernelGGL(hymba_fwd, dim3(grid), dim3(NWAVES * 64), LDS_BYTES, stream, a);
        if (PROBE_P1 >= 0) { a.ph_lo = 1; a.ph_hi = 2; a.li = 1; a.qw = 1; a.pmode = PROBE_P1; a.sub = 3; hipLaunchKernelGGL(hymba_fwd, dim3(grid), dim3(NWAVES * 64), LDS_BYTES, stream, a); a.pmode = 0; }
        if (PROBE_FUSED >= 0) { a.ph_lo = 2; a.ph_hi = 4; a.li = 1; a.qw = 1; a.pmode = PROBE_FUSED; hipLaunchKernelGGL(hymba_fwd, dim3(grid), dim3(NWAVES * 64), LDS_BYTES, stream, a); }
    }
    else {
        const int ph[6] = {0, 1, 2, 2, 2, 3}, sub[6] = {3, 3, 1, 1, 2, 3}, ulo[6] = {0, 0, 64, 0, 0, 0}, uhi[6] = {0, 0, 192, 64, 0, 0};
        for (int li = 0; li < 6; ++li) for (int rep = 0; rep < (li == PROBE_REP ? 2 : 1); ++rep) {
            a.ph_lo = ph[li]; a.ph_hi = ph[li] + 1; a.sub = sub[li]; a.ulo = ulo[li]; a.uhi = uhi[li]; a.qw = li * 2 + rep;
            hipLaunchKernelGGL(hymba_fwd, dim3(grid), dim3(NWAVES * 64), LDS_BYTES, stream, a);
            if (li == 1 && PROBE_MODE == 10) { a.sub = 3 | 4; hipLaunchKernelGGL(hymba_fwd, dim3(grid), dim3(NWAVES * 64), LDS_BYTES, stream, a); }
            if (li == 2 && PROBE_MODE >= 0 && PROBE_MODE < 10) { a.qw = 13; a.pmode = PROBE_MODE; hipLaunchKernelGGL(hymba_fwd, dim3(grid), dim3(NWAVES * 64), LDS_BYTES, stream, a); a.pmode = 0; } }
    }
}
```
